# Optimizing an MI355X kernel written in HIP

```python
import numpy as np
import jax
import jax.numpy as jnp
from jax import lax


D_MODEL = 1024
BATCH = 8
SEQ = 2048
DEPTH = 2

ROPE_THETA = 10000.0
NORM_EPS = 1e-6
NEG_INF = -1e30
FORCED_SCORE = 1e4

MLSTM_HEADS = 4
MLSTM_DH = D_MODEL // 8
MLSTM_W = MLSTM_HEADS * MLSTM_DH
MLSTM_CHUNK = 64
MLSTM_CONV = 4
MLSTM_GATE_CAP = 15.0
MOBA_HEADS = 4
MOBA_DH = D_MODEL // 8
MOBA_W = MOBA_HEADS * MOBA_DH
MOBA_BLOCK = 256
MOBA_TOPK = 3
MOBA_QCHUNK = 16
EVEN_SPLITS = (2 * MLSTM_W, 3 * MLSTM_W, 4 * MLSTM_W, 4 * MLSTM_W + 2 * MLSTM_HEADS,
               4 * MLSTM_W + 2 * MLSTM_HEADS + MOBA_W, 4 * MLSTM_W + 2 * MLSTM_HEADS + 2 * MOBA_W)
EVEN_IN = 4 * MLSTM_W + 2 * MLSTM_HEADS + 3 * MOBA_W

NSA_HEADS = 8
NSA_GROUPS = 2
NSA_REP = NSA_HEADS // NSA_GROUPS
NSA_DH = D_MODEL // 8
NSA_W = NSA_HEADS * NSA_DH
NSA_KV_W = NSA_GROUPS * NSA_DH
CMP_LEN = 32
CMP_STRIDE = 16
CMP_HIDDEN = 256
SEL_BLOCK = 64
SEL_TOPN = 8
WINDOW = 512
NSA_QCHUNK = 32
ODD_SPLITS = (NSA_W, NSA_W + NSA_KV_W, NSA_W + 2 * NSA_KV_W, NSA_W + 3 * NSA_KV_W,
              NSA_W + 4 * NSA_KV_W, NSA_W + 5 * NSA_KV_W, NSA_W + 6 * NSA_KV_W)
ODD_IN = NSA_W + 6 * NSA_KV_W + 3 * NSA_HEADS

MOE_GROUPS = 4
MOE_EXPERTS_PER_GROUP = 4
MOE_EXPERTS = MOE_GROUPS * MOE_EXPERTS_PER_GROUP
MOE_TOPK = 2
MOE_HIDDEN = D_MODEL // 4

kernel_name = 'hybrid_mlstm_moba_nsa_hmoe'


def rms_norm(x, g):
    xf = x.astype(jnp.float32)
    y = xf * lax.rsqrt(jnp.mean(xf * xf, axis=-1, keepdims=True) + NORM_EPS)
    return (y * g.astype(jnp.float32)).astype(x.dtype)


def rotary(x):
    S, Dh = x.shape[-2], x.shape[-1]
    half = Dh // 2
    inv = ROPE_THETA ** (-(jnp.arange(half, dtype=jnp.float32) / half))
    ang = jnp.arange(S, dtype=jnp.float32)[:, None] * inv[None, :]
    cos, sin = jnp.cos(ang), jnp.sin(ang)
    xf = x.astype(jnp.float32)
    x1, x2 = xf[..., :half], xf[..., half:]
    return jnp.concatenate([x1 * cos - x2 * sin, x2 * cos + x1 * sin], axis=-1).astype(x.dtype)


def masked_softmax(s, mask):
    s = jnp.where(mask, s.astype(jnp.float32), NEG_INF)
    e = jnp.where(mask, jnp.exp(s - jnp.max(s, axis=-1, keepdims=True)), 0.0)
    return e / jnp.maximum(jnp.sum(e, axis=-1, keepdims=True), 1e-30)


def split_heads(t, n, d):
    B, S, _ = t.shape
    return t.reshape(B, S, n, d).transpose(0, 2, 1, 3)


def merge_heads(t):
    B, n, S, d = t.shape
    return t.transpose(0, 2, 1, 3).reshape(B, S, n * d)


def causal_depthwise_conv(x, w):
    K, C = w.shape
    return lax.conv_general_dilated(x, w[:, None, :].astype(x.dtype), window_strides=(1,),
                                    padding=[(K - 1, 0)], dimension_numbers=('NWC', 'WIO', 'NWC'),
                                    feature_group_count=C)


def mlstm_chunkwise(q, k, v, log_i, log_f):
    B, H, S, Dh = q.shape
    L = MLSTM_CHUNK
    NC = S // L
    f32 = jnp.float32
    q = q.astype(f32).reshape(B, H, NC, L, Dh) * (Dh ** -0.5)
    k = k.astype(f32).reshape(B, H, NC, L, Dh)
    v = v.astype(f32).reshape(B, H, NC, L, Dh)
    log_i = log_i.astype(f32).reshape(B, H, NC, L)
    b = jnp.cumsum(log_f.astype(f32).reshape(B, H, NC, L), axis=-1)
    b_last = b[..., -1]
    g = b_last[..., None] - b + log_i
    g_max = jnp.max(g, axis=-1)
    w = jnp.exp(g - g_max[..., None])
    kv = jnp.einsum('bhcs,bhcse,bhcsd->bhced', w, v, k)
    ksum = jnp.einsum('bhcs,bhcsd->bhcd', w, k)

    def step(carry, xs):
        C, n, m = carry
        kv_c, ks_c, gm_c, bl_c = xs
        m_new = jnp.maximum(bl_c + m, gm_c)
        a = jnp.exp(bl_c + m - m_new)
        c = jnp.exp(gm_c - m_new)
        C_new = a[..., None, None] * C + c[..., None, None] * kv_c
        n_new = a[..., None] * n + c[..., None] * ks_c
        return (C_new, n_new, m_new), (C, n, m)

    init = (jnp.zeros((B, H, Dh, Dh), f32), jnp.zeros((B, H, Dh), f32), jnp.zeros((B, H), f32))
    xs = (jnp.moveaxis(kv, 2, 0), jnp.moveaxis(ksum, 2, 0), jnp.moveaxis(g_max, 2, 0), jnp.moveaxis(b_last, 2, 0))
    _, (C_in, n_in, m_in) = lax.scan(step, init, xs)
    C_in = jnp.moveaxis(C_in, 0, 2)
    n_in = jnp.moveaxis(n_in, 0, 2)
    m_in = jnp.moveaxis(m_in, 0, 2)
    causal = jnp.tril(jnp.ones((L, L), dtype=bool))
    dmat = jnp.where(causal, b[..., :, None] - b[..., None, :] + log_i[..., None, :], NEG_INF)
    inter = b + m_in[..., None]
    m_t = jnp.maximum(inter, jnp.max(dmat, axis=-1))
    s = jnp.einsum('bhctd,bhcsd->bhcts', q, k) * jnp.exp(dmat - m_t[..., None])
    w_inter = jnp.exp(inter - m_t)
    num = jnp.einsum('bhcts,bhcse->bhcte', s, v) + w_inter[..., None] * jnp.einsum('bhced,bhctd->bhcte', C_in, q)
    den = jnp.sum(s, axis=-1) + w_inter * jnp.einsum('bhcd,bhctd->bhct', n_in, q)
    h = num / jnp.maximum(jnp.abs(den), jnp.exp(-m_t))[..., None]
    return h.reshape(B, H, S, Dh)


def moba_attention(q, k, v):
    B, H, S, Dh = q.shape
    BS = MOBA_BLOCK
    NB = -(-S // BS)
    pad = NB * BS - S
    kp = jnp.pad(k, ((0, 0), (0, 0), (0, pad), (0, 0)))
    vp = jnp.pad(v, ((0, 0), (0, 0), (0, pad), (0, 0)))
    kb = kp.reshape(B, H, NB, BS, Dh)
    vb = vp.reshape(B, H, NB, BS, Dh)
    counts = np.minimum(BS, S - np.arange(NB) * BS).astype(np.float32)
    k_mean = jnp.sum(kb.astype(jnp.float32), axis=3) / counts[:, None]
    gate = jnp.einsum('bhsd,bhnd->bhsn', q.astype(jnp.float32), k_mean)
    pos = jnp.arange(S)
    past = jnp.arange(NB)[None, :] < (pos // BS)[:, None]
    gate = jnp.where(past, gate, NEG_INF)
    k_sel = min(MOBA_TOPK, NB)
    top_val, top_idx = lax.top_k(gate, k_sel)
    top_ok = top_val > 0.5 * NEG_INF
    scale = Dh ** -0.5
    Q = MOBA_QCHUNK
    bi = jnp.arange(B)[:, None, None, None]
    hi = jnp.arange(H)[None, :, None, None]

    def chunk(c):
        t0 = c * Q
        tq = t0 + jnp.arange(Q)
        qc = lax.dynamic_slice_in_dim(q, t0, Q, axis=2)
        idx = lax.dynamic_slice_in_dim(top_idx, t0, Q, axis=2)
        ok = lax.dynamic_slice_in_dim(top_ok, t0, Q, axis=2)
        kg = kb[bi, hi, idx]
        vg = vb[bi, hi, idx].reshape(B, H, Q, k_sel * BS, Dh)
        s_sel = jnp.einsum('bhqd,bhqnpd->bhqnp', qc, kg).reshape(B, H, Q, k_sel * BS)
        m_sel = jnp.repeat(ok, BS, axis=-1)
        blk0 = (t0 // BS) * BS
        k_own = lax.dynamic_slice_in_dim(kp, blk0, BS, axis=2)
        v_own = lax.dynamic_slice_in_dim(vp, blk0, BS, axis=2)
        s_own = jnp.einsum('bhqd,bhpd->bhqp', qc, k_own)
        m_own = (blk0 + jnp.arange(BS))[None, :] <= tq[:, None]
        s_all = jnp.concatenate([s_sel, s_own], axis=-1).astype(jnp.float32) * scale
        m_all = jnp.concatenate([m_sel, jnp.broadcast_to(m_own, (B, H, Q, BS))], axis=-1)
        p = masked_softmax(s_all, m_all).astype(v.dtype)
        return (jnp.einsum('bhqk,bhqkd->bhqd', p[..., :k_sel * BS], vg)
                + jnp.einsum('bhqp,bhpd->bhqd', p[..., k_sel * BS:], v_own))

    outs = lax.map(chunk, jnp.arange(S // Q))
    return outs.transpose(1, 2, 0, 3, 4).reshape(B, H, S, Dh)


def even_mixer(h, w_in, conv_w, gate_b, head_gain, w_out):
    B, S, _ = h.shape
    z = h @ w_in
    qk_m, v_m, o_m, if_m, q_b, k_b, v_b = jnp.split(z, EVEN_SPLITS, axis=-1)
    qk_m = jax.nn.silu(causal_depthwise_conv(qk_m, conv_w))
    q_m, k_m = jnp.split(qk_m, 2, axis=-1)
    pre = if_m.astype(jnp.float32) + gate_b.astype(jnp.float32)
    pre = MLSTM_GATE_CAP * jnp.tanh(pre / MLSTM_GATE_CAP)
    log_i = pre[..., :MLSTM_HEADS].transpose(0, 2, 1)
    log_f = jax.nn.log_sigmoid(pre[..., MLSTM_HEADS:]).transpose(0, 2, 1)
    h_t = mlstm_chunkwise(split_heads(q_m, MLSTM_HEADS, MLSTM_DH), split_heads(k_m, MLSTM_HEADS, MLSTM_DH),
                          split_heads(v_m, MLSTM_HEADS, MLSTM_DH), log_i, log_f)
    h_t = (h_t * lax.rsqrt(jnp.mean(h_t * h_t, axis=-1, keepdims=True) + NORM_EPS)
           * head_gain.astype(jnp.float32).reshape(MLSTM_HEADS, 1, MLSTM_DH))
    h_m = (merge_heads(h_t) * jax.nn.sigmoid(o_m.astype(jnp.float32))).astype(h.dtype)
    o_b = moba_attention(rotary(split_heads(q_b, MOBA_HEADS, MOBA_DH)), rotary(split_heads(k_b, MOBA_HEADS, MOBA_DH)),
                         split_heads(v_b, MOBA_HEADS, MOBA_DH))
    y = jnp.concatenate([h_m, merge_heads(o_b).astype(h.dtype)], axis=-1)
    return y @ w_out


def odd_mixer(h, w_in, cmp_pos, w_ck1, w_ck2, w_cv1, w_cv2, w_out):
    B, S, _ = h.shape
    dt = h.dtype
    G, R, Dh = NSA_GROUPS, NSA_REP, NSA_DH
    scale = Dh ** -0.5
    z = h @ w_in
    q, k_c, v_c, k_s, v_s, k_w, v_w, gate = jnp.split(z, ODD_SPLITS, axis=-1)
    q = q.reshape(B, S, G, R, Dh).transpose(0, 2, 3, 1, 4)
    k_c, v_c, k_s, v_s, k_w, v_w = [split_heads(t, G, Dh) for t in (k_c, v_c, k_s, v_s, k_w, v_w)]
    n_cmp = (S - CMP_LEN) // CMP_STRIDE + 1
    cmp_start = np.arange(n_cmp) * CMP_STRIDE
    cmp_end = cmp_start + CMP_LEN - 1
    blk_idx = cmp_start[:, None] + np.arange(CMP_LEN)[None, :]

    def compress(t, pe, w1, w2):
        tb = (t[:, :, blk_idx] + pe).reshape(B, G, n_cmp, CMP_LEN * Dh)
        return jax.nn.gelu(tb @ w1) @ w2

    k_cmp = compress(k_c, cmp_pos[0], w_ck1, w_ck2)
    v_cmp = compress(v_c, cmp_pos[1], w_cv1, w_cv2)
    pos = jnp.arange(S)
    cmp_ok = cmp_end[None, :] <= pos[:, None]
    p_cmp = masked_softmax(jnp.einsum('bgrsd,bgnd->bgrsn', q, k_cmp) * scale, cmp_ok)
    o_cmp = jnp.einsum('bgrsn,bgnd->bgrsd', p_cmp.astype(dt), v_cmp)
    n_blk = S // SEL_BLOCK
    blk_lo = np.arange(n_blk) * SEL_BLOCK
    overlap = ((cmp_start[:, None] <= blk_lo[None, :] + SEL_BLOCK - 1)
               & (cmp_end[:, None] >= blk_lo[None, :])).astype(np.float32)
    imp = jnp.einsum('bgrsn,nj->bgsj', p_cmp, overlap)
    cur = (pos // SEL_BLOCK)[:, None]
    jb = jnp.arange(n_blk)[None, :]
    forced = (jb == 0) | (jb == cur) | (jb == cur - 1)
    imp = jnp.where(jb <= cur, jnp.where(forced, FORCED_SCORE, imp), NEG_INF)
    n_sel = min(SEL_TOPN, n_blk)
    sel_val, sel_idx = lax.top_k(imp, n_sel)
    sel_ok = sel_val > 0.5 * NEG_INF
    q_r = rotary(q)
    k_sb = rotary(k_s).reshape(B, G, n_blk, SEL_BLOCK, Dh)
    v_sb = v_s.reshape(B, G, n_blk, SEL_BLOCK, Dh)
    k_wp = jnp.pad(rotary(k_w), ((0, 0), (0, 0), (WINDOW, 0), (0, 0)))
    v_wp = jnp.pad(v_w, ((0, 0), (0, 0), (WINDOW, 0), (0, 0)))
    Q = NSA_QCHUNK
    bi = jnp.arange(B)[:, None, None, None]
    gi = jnp.arange(G)[None, :, None, None]

    def chunk(c):
        t0 = c * Q
        tq = t0 + jnp.arange(Q)
        qc = lax.dynamic_slice_in_dim(q_r, t0, Q, axis=3)
        idx = lax.dynamic_slice_in_dim(sel_idx, t0, Q, axis=2)
        ok = lax.dynamic_slice_in_dim(sel_ok, t0, Q, axis=2)
        kg = k_sb[bi, gi, idx].reshape(B, G, Q, n_sel * SEL_BLOCK, Dh)
        vg = v_sb[bi, gi, idx].reshape(B, G, Q, n_sel * SEL_BLOCK, Dh)
        tk = (idx[..., None] * SEL_BLOCK + jnp.arange(SEL_BLOCK)).reshape(B, G, Q, n_sel * SEL_BLOCK)
        m_sel = jnp.repeat(ok, SEL_BLOCK, axis=-1) & (tk <= tq[:, None])
        p_s = masked_softmax(jnp.einsum('bgrqd,bgqkd->bgrqk', qc, kg) * scale, m_sel[:, :, None])
        o_s = jnp.einsum('bgrqk,bgqkd->bgrqd', p_s.astype(dt), vg)
        k_win = lax.dynamic_slice_in_dim(k_wp, t0, WINDOW + Q, axis=2)
        v_win = lax.dynamic_slice_in_dim(v_wp, t0, WINDOW + Q, axis=2)
        tw = t0 - WINDOW + jnp.arange(WINDOW + Q)
        gap = tq[:, None] - tw[None, :]
        m_win = (tw[None, :] >= 0) & (gap >= 0) & (gap < WINDOW)
        p_w = masked_softmax(jnp.einsum('bgrqd,bgkd->bgrqk', qc, k_win) * scale, m_win)
        o_w = jnp.einsum('bgrqk,bgkd->bgrqd', p_w.astype(dt), v_win)
        return o_s, o_w

    o_sel, o_win = lax.map(chunk, jnp.arange(S // Q))
    o_sel = o_sel.transpose(1, 2, 3, 0, 4, 5).reshape(B, G, R, S, Dh)
    o_win = o_win.transpose(1, 2, 3, 0, 4, 5).reshape(B, G, R, S, Dh)
    g = jax.nn.sigmoid(gate.astype(jnp.float32)).reshape(B, S, G, R, 3).transpose(0, 2, 3, 1, 4).astype(dt)
    o = g[..., 0:1] * o_cmp + g[..., 1:2] * o_sel + g[..., 2:3] * o_win
    o = o.transpose(0, 3, 1, 2, 4).reshape(B, S, NSA_W)
    return o @ w_out


def hier_moe(x, w_g, b_g, w_e, b_e, w1, w3, w2):
    B, S, D = x.shape
    T = B * S
    xt = x.reshape(T, D)
    xf = xt.astype(jnp.float32)
    g_logits = xf @ w_g.astype(jnp.float32) + b_g.astype(jnp.float32)
    g_prob = jax.nn.softmax(g_logits, axis=-1)
    g_top = jnp.argmax(g_logits, axis=-1)
    g_w = jnp.take_along_axis(g_prob, g_top[:, None], axis=-1)
    e_logits = (xf @ w_e.astype(jnp.float32) + b_e.astype(jnp.float32)).reshape(T, MOE_GROUPS, MOE_EXPERTS_PER_GROUP)
    e_in = jnp.take_along_axis(e_logits, g_top[:, None, None], axis=1)[:, 0]
    top_v, top_i = lax.top_k(e_in, MOE_TOPK)
    w_top = jax.nn.softmax(top_v, axis=-1) * g_w
    eid = g_top[:, None] * MOE_EXPERTS_PER_GROUP + top_i
    combine = jnp.einsum('tk,tke->te', w_top, jax.nn.one_hot(eid, MOE_EXPERTS, dtype=jnp.float32))
    out = jnp.zeros((T, D), jnp.float32)
    for e in range(MOE_EXPERTS):
        hdn = jax.nn.silu(xt @ w1[e]) * (xt @ w3[e])
        out = out + combine[:, e:e + 1] * (hdn @ w2[e]).astype(jnp.float32)
    return out.astype(x.dtype).reshape(B, S, D)


def setup_inputs(seed: int = 0) -> dict:
    key = jax.random.key(seed)
    keys = iter(jax.random.split(key, 64))
    D = D_MODEL

    def nrm(shape, scale):
        return jax.random.normal(next(keys), shape, jnp.float32) * scale

    def gain(n):
        return 1.0 + nrm((n,), 0.02)

    inp = {}
    inp['x'] = nrm((BATCH, SEQ, D), 1.0)
    inp['mix_norm_0'] = gain(D)
    inp['w_in_0'] = nrm((D, EVEN_IN), D ** -0.5)
    inp['mlstm_conv_0'] = nrm((MLSTM_CONV, 2 * MLSTM_W), MLSTM_CONV ** -0.5)
    inp['mlstm_gate_b_0'] = jnp.concatenate([nrm((MLSTM_HEADS,), 0.1),
                                             jnp.linspace(3.0, 6.0, MLSTM_HEADS, dtype=jnp.float32) + nrm((MLSTM_HEADS,), 0.1)])
    inp['mlstm_head_norm_0'] = gain(MLSTM_W)
    inp['w_out_0'] = nrm((MLSTM_W + MOBA_W, D), (MLSTM_W + MOBA_W) ** -0.5)

    def add_moe(i):
        inp[f'ffn_norm_{i}'] = gain(D)
        inp[f'router_group_{i}'] = nrm((D, MOE_GROUPS), D ** -0.5)
        inp[f'router_group_b_{i}'] = nrm((MOE_GROUPS,), 0.01)
        inp[f'router_expert_{i}'] = nrm((D, MOE_EXPERTS), D ** -0.5)
        inp[f'router_expert_b_{i}'] = nrm((MOE_EXPERTS,), 0.01)
        inp[f'moe_w1_{i}'] = nrm((MOE_EXPERTS, D, MOE_HIDDEN), D ** -0.5)
        inp[f'moe_w3_{i}'] = nrm((MOE_EXPERTS, D, MOE_HIDDEN), D ** -0.5)
        inp[f'moe_w2_{i}'] = nrm((MOE_EXPERTS, MOE_HIDDEN, D), MOE_HIDDEN ** -0.5)

    add_moe(0)
    inp['mix_norm_1'] = gain(D)
    inp['w_in_1'] = nrm((D, ODD_IN), D ** -0.5)
    inp['nsa_cmp_pos_1'] = nrm((2, CMP_LEN, NSA_DH), 0.1)
    inp['nsa_cmp_k1_1'] = nrm((CMP_LEN * NSA_DH, CMP_HIDDEN), (CMP_LEN * NSA_DH) ** -0.5)
    inp['nsa_cmp_k2_1'] = nrm((CMP_HIDDEN, NSA_DH), CMP_HIDDEN ** -0.5)
    inp['nsa_cmp_v1_1'] = nrm((CMP_LEN * NSA_DH, CMP_HIDDEN), (CMP_LEN * NSA_DH) ** -0.5)
    inp['nsa_cmp_v2_1'] = nrm((CMP_HIDDEN, NSA_DH), CMP_HIDDEN ** -0.5)
    inp['w_out_1'] = nrm((NSA_W, D), NSA_W ** -0.5)
    add_moe(1)
    inp['final_norm'] = gain(D)
    return inp


def reference(x, mix_norm_0, w_in_0, mlstm_conv_0, mlstm_gate_b_0, mlstm_head_norm_0, w_out_0,
              ffn_norm_0, router_group_0, router_group_b_0, router_expert_0, router_expert_b_0,
              moe_w1_0, moe_w3_0, moe_w2_0,
              mix_norm_1, w_in_1, nsa_cmp_pos_1, nsa_cmp_k1_1, nsa_cmp_k2_1, nsa_cmp_v1_1, nsa_cmp_v2_1, w_out_1,
              ffn_norm_1, router_group_1, router_group_b_1, router_expert_1, router_expert_b_1,
              moe_w1_1, moe_w3_1, moe_w2_1,
              final_norm):
    mix_norms = (mix_norm_0, mix_norm_1)
    mixers = ((even_mixer, (w_in_0, mlstm_conv_0, mlstm_gate_b_0, mlstm_head_norm_0, w_out_0)),
              (odd_mixer, (w_in_1, nsa_cmp_pos_1, nsa_cmp_k1_1, nsa_cmp_k2_1, nsa_cmp_v1_1, nsa_cmp_v2_1, w_out_1)))
    ffn_norms = (ffn_norm_0, ffn_norm_1)
    moes = ((router_group_0, router_group_b_0, router_expert_0, router_expert_b_0, moe_w1_0, moe_w3_0, moe_w2_0),
            (router_group_1, router_group_b_1, router_expert_1, router_expert_b_1, moe_w1_1, moe_w3_1, moe_w2_1))
    h = x
    for layer in range(DEPTH):
        mixer, params = mixers[layer]
        h = h + mixer(rms_norm(h, mix_norms[layer]), *params)
        h = h + hier_moe(rms_norm(h, ffn_norms[layer]), *moes[layer])
    return rms_norm(h, final_norm)
```

```cpp
#include <hip/hip_runtime.h>
#include <stdint.h>
#include <math.h>

#define T_ 16384
#define S_ 2048
#define D_ 1024
#define NEGINF (-1e30f)

typedef unsigned short bf16;
__device__ __forceinline__ float bf2f(bf16 v) { return __uint_as_float(((unsigned)v) << 16); }
__device__ __forceinline__ bf16 f2bf(float f) { unsigned u = __float_as_uint(f); return (bf16)((u + 0x7fffu + ((u >> 16) & 1u)) >> 16); }
__device__ __forceinline__ float lo16(unsigned u) { return __uint_as_float(u << 16); }
__device__ __forceinline__ float hi16(unsigned u) { return __uint_as_float(u & 0xffff0000u); }
__device__ __forceinline__ float wave_sum(float v) {
#pragma unroll
    for (int o = 32; o > 0; o >>= 1) v += __shfl_xor(v, o);
    return v; }
__device__ __forceinline__ float wave_max(float v) {
#pragma unroll
    for (int o = 32; o > 0; o >>= 1) v = fmaxf(v, __shfl_xor(v, o));
    return v; }
__device__ __forceinline__ float sigmoidf_(float x) { return 1.f / (1.f + __expf(-x)); }

constexpr size_t MiB = 1ull << 20;
constexpr size_t WS_CTL = 0;
constexpr size_t WS_WB = 1 * MiB;
constexpr size_t WS_R0 = 69 * MiB;
constexpr size_t WS_R1 = 101 * MiB;
constexpr size_t WS_R2 = 133 * MiB;
constexpr size_t WS_R3 = 165 * MiB;
constexpr size_t WS_R4 = 197 * MiB;
constexpr size_t WS_R5 = 229 * MiB;
constexpr size_t WS_SM = 245 * MiB;
constexpr size_t SM_IF = 0;
constexpr size_t SM_LI = SM_IF + 512 * 1024;
constexpr size_t SM_BC = SM_LI + 256 * 1024;
constexpr size_t SM_KMEAN = SM_BC + 256 * 1024;
constexpr size_t SM_LIST = SM_KMEAN + 128 * 1024;
constexpr size_t SM_LISTW = SM_LIST + 1 * MiB;
constexpr size_t SM_SELM = SM_LISTW + 1 * MiB;
constexpr size_t SM_G = SM_SELM + 128 * 1024;
constexpr size_t SM_HC = SM_G + 1536 * 1024;
constexpr size_t SM_KCMP = SM_HC + 2 * MiB;
constexpr size_t SM_VCMPT = SM_KCMP + 512 * 1024;
constexpr size_t SM_END = SM_VCMPT + 512 * 1024;
static_assert(SM_END <= 11 * MiB, "small region");
constexpr int CW_CNT = 1024;
constexpr int CW_EB = 1088;

template <class G, bool DUAL>
__global__ void __launch_bounds__(256) k_gemm_naive(G g) {
    __shared__ float As[16][68];
    __shared__ float Ws[DUAL ? 2 : 1][16][68];
    const int z = blockIdx.z, tile_m = blockIdx.x * 64, tile_n = blockIdx.y * 64, tid = threadIdx.x;
    const int M = g.M(z);
    if (tile_m >= M) return;
    const int tx = tid & 15, ty = tid >> 4;
    float acc[4][4], acc2[4][4];
#pragma unroll
    for (int i = 0; i < 4; ++i)
#pragma unroll
        for (int j = 0; j < 4; ++j) { acc[i][j] = 0.f; acc2[i][j] = 0.f; }
    const int ar = tid >> 2, ak = (tid & 3) * 4;
    const bf16* arow = (tile_m + ar < M) ? g.arow(z, tile_m + ar) : nullptr;
    const int wk = tid >> 4, wn = (tid & 15) * 4;
    const float* Wp = g.W(z);
    const float* Wp2 = DUAL ? g.W2(z) : nullptr;
    const bool wok = (tile_n + wn) < g.N;
    for (int k0 = 0; k0 < g.K; k0 += 16) {
        float a4[4] = {0.f, 0.f, 0.f, 0.f};
        if (arow) { const uint2 u = *(const uint2*)(arow + k0 + ak); a4[0] = lo16(u.x); a4[1] = hi16(u.x); a4[2] = lo16(u.y); a4[3] = hi16(u.y);
            if (g.abias) { const float4 bb = *(const float4*)(g.abias + k0 + ak); a4[0] += bb.x; a4[1] += bb.y; a4[2] += bb.z; a4[3] += bb.w; } }
        float4 w4 = make_float4(0.f, 0.f, 0.f, 0.f), w42 = w4;
        if (wok) { w4 = *(const float4*)(Wp + (size_t)(k0 + wk) * g.ldw + tile_n + wn); if (DUAL) w42 = *(const float4*)(Wp2 + (size_t)(k0 + wk) * g.ldw + tile_n + wn); }
        __syncthreads();
#pragma unroll
        for (int i = 0; i < 4; ++i) As[ak + i][ar] = a4[i];
        Ws[0][wk][wn + 0] = w4.x; Ws[0][wk][wn + 1] = w4.y; Ws[0][wk][wn + 2] = w4.z; Ws[0][wk][wn + 3] = w4.w;
        if (DUAL) { Ws[DUAL ? 1 : 0][wk][wn + 0] = w42.x; Ws[DUAL ? 1 : 0][wk][wn + 1] = w42.y; Ws[DUAL ? 1 : 0][wk][wn + 2] = w42.z; Ws[DUAL ? 1 : 0][wk][wn + 3] = w42.w; }
        __syncthreads();
#pragma unroll
        for (int kk = 0; kk < 16; ++kk) {
            float a[4], w[4], w2[4];
#pragma unroll
            for (int i = 0; i < 4; ++i) a[i] = As[kk][ty * 4 + i];
#pragma unroll
            for (int j = 0; j < 4; ++j) { w[j] = Ws[0][kk][tx * 4 + j]; w2[j] = DUAL ? Ws[DUAL ? 1 : 0][kk][tx * 4 + j] : 0.f; }
#pragma unroll
            for (int i = 0; i < 4; ++i)
#pragma unroll
                for (int j = 0; j < 4; ++j) { acc[i][j] += a[i] * w[j]; if (DUAL) acc2[i][j] += a[i] * w2[j]; }
        }
    }
#pragma unroll
    for (int i = 0; i < 4; ++i)
#pragma unroll
        for (int j = 0; j < 4; ++j) { const int m = tile_m + ty * 4 + i, n = tile_n + tx * 4 + j; if (m < M && n < g.N) g.store(z, m, n, acc[i][j], acc2[i][j]); }
}

struct GProj0 {
    const bf16* xn; const float* w; bf16 *qkraw, *vmt, *om, *qb, *kb, *vbt; const float* abias; int N, K, ldw;
    __device__ int M(int) const { return T_; }
    __device__ const bf16* arow(int, int m) const { return xn + (size_t)m * D_; }
    __device__ const float* W(int) const { return w; }
    __device__ const float* W2(int) const { return w; }
    __device__ void store(int, int m, int n, float v, float) const {
        const int b = m >> 11, s = m & 2047; const bf16 o = f2bf(v);
        if (n < 1024) qkraw[(size_t)m * 1024 + n] = o;
        else if (n < 1536) { const int c = n - 1024; vmt[((size_t)(b * 4 + (c >> 7)) * 128 + (c & 127)) * 2048 + s] = o; }
        else if (n < 2048) om[(size_t)m * 512 + (n - 1536)] = o;
        else if (n < 2056) {}
        else if (n < 2568) { const int c = n - 2056; qb[((size_t)(b * 4 + (c >> 7)) * 2048 + s) * 128 + (c & 127)] = o; }
        else if (n < 3080) { const int c = n - 2568; kb[((size_t)(b * 4 + (c >> 7)) * 2048 + s) * 128 + (c & 127)] = o; }
        else { const int c = n - 3080; vbt[((size_t)(b * 4 + (c >> 7)) * 128 + (c & 127)) * 2048 + s] = o; }
    }
};
struct GProj1 {
    const bf16* xn; const float* w; bf16 *q1, *kc, *vc, *ks, *vst, *kw, *vwt; const float* abias; int N, K, ldw;
    __device__ int M(int) const { return T_; }
    __device__ const bf16* arow(int, int m) const { return xn + (size_t)m * D_; }
    __device__ const float* W(int) const { return w; }
    __device__ const float* W2(int) const { return w; }
    __device__ void store(int, int m, int n, float v, float) const {
        const int b = m >> 11, s = m & 2047; const bf16 o = f2bf(v);
        if (n < 1024) q1[((size_t)(b * 8 + (n >> 7)) * 2048 + s) * 128 + (n & 127)] = o;
        else if (n < 2560) { const int c = n - 1024, which = c >> 8, cc = c & 255, gI = cc >> 7, d = cc & 127;
            const size_t hm = ((size_t)(b * 2 + gI) * 2048 + s) * 128 + d, tm = ((size_t)(b * 2 + gI) * 128 + d) * 2048 + s;
            if (which == 0) kc[hm] = o; else if (which == 1) vc[hm] = o; else if (which == 2) ks[hm] = o; else if (which == 3) vst[tm] = o; else if (which == 4) kw[hm] = o; else vwt[tm] = o; }
    }
};
struct GOut {
    const bf16* y; const float* w; const float* hin; float* hout; const float* abias; int N, K, ldw;
    __device__ int M(int) const { return T_; }
    __device__ const bf16* arow(int, int m) const { return y + (size_t)m * D_; }
    __device__ const float* W(int) const { return w; }
    __device__ const float* W2(int) const { return w; }
    __device__ void store(int, int m, int n, float v, float) const { const size_t i = (size_t)m * D_ + n; hout[i] = hin[i] + v; }
};
struct GMoe1 {
    const bf16* xn; const float* w1; const float* w3; const int* cnt; const int* eb; const int* list; bf16* H; const float* abias; int N, K, ldw;
    __device__ int M(int z) const { return cnt[z]; }
    __device__ const bf16* arow(int z, int m) const { return xn + (size_t)(list[z * T_ + m] >> 1) * D_; }
    __device__ const float* W(int z) const { return w1 + (size_t)z * 1024 * 256; }
    __device__ const float* W2(int z) const { return w3 + (size_t)z * 1024 * 256; }
    __device__ void store(int z, int m, int n, float a, float b) const { H[(size_t)(eb[z] + m) * 256 + n] = f2bf(a * sigmoidf_(a) * b); }
};
struct GMoe2 {
    const bf16* H; const float* w2; const int* cnt; const int* eb; const int* list; const float* listw; bf16* ys0; bf16* ys1; const float* abias; int N, K, ldw;
    __device__ int M(int z) const { return cnt[z]; }
    __device__ const bf16* arow(int z, int m) const { return H + (size_t)(eb[z] + m) * 256; }
    __device__ const float* W(int z) const { return w2 + (size_t)z * 256 * 1024; }
    __device__ const float* W2(int z) const { return w2; }
    __device__ void store(int z, int m, int n, float v, float) const { const int e = list[z * T_ + m]; const float w = listw[z * T_ + m];
        bf16* ys = (e & 1) ? ys1 : ys0; ys[(size_t)(e >> 1) * D_ + n] = f2bf(w * v); }
};
struct GCmp1 {
    const bf16* kc; const bf16* vc; const float* wk1; const float* wv1; const float* pe; bf16* hc; const float* abias; int N, K, ldw;
    __device__ int M(int) const { return 2048; }
    __device__ const bf16* arow(int z, int r) const { const int bg = r >> 7, nb = r & 127; if (nb == 127) return nullptr; return (z ? vc : kc) + ((size_t)bg * 2048 + 16 * nb) * 128; }
    __device__ const float* W(int z) const { return z ? wv1 : wk1; }
    __device__ const float* W2(int z) const { return wk1; }
    __device__ void store(int z, int r, int n, float v, float) const { const float u = 0.7978845608028654f * (v + 0.044715f * v * v * v); hc[((size_t)z * 2048 + r) * 256 + n] = f2bf(0.5f * v * (1.f + tanhf(u))); }
};
struct GCmp2 {
    const bf16* hc; const float* wk2; const float* wv2; bf16* kcmp; bf16* vcmpt; const float* abias; int N, K, ldw;
    __device__ int M(int) const { return 2048; }
    __device__ const bf16* arow(int z, int r) const { return hc + ((size_t)z * 2048 + r) * 256; }
    __device__ const float* W(int z) const { return z ? wv2 : wk2; }
    __device__ const float* W2(int z) const { return wk2; }
    __device__ void store(int z, int r, int n, float v, float) const { const int bg = r >> 7, nb = r & 127; const float vv = (nb == 127) ? 0.f : v;
        if (z == 0) kcmp[((size_t)bg * 128 + nb) * 128 + n] = f2bf(vv); else vcmpt[((size_t)bg * 128 + n) * 128 + nb] = f2bf(vv); }
};

struct RowNormArgs { const float* base; const bf16* add0; const bf16* add1; float* hout; const float* gain; bf16* xn; float* fout;
                     const float* auxW; int auxLd; int naux; int auxAct; float* auxOut; };
__global__ void __launch_bounds__(256) k_rownorm(RowNormArgs a) {
    const int row = (blockIdx.x * 256 + threadIdx.x) >> 6, lane = threadIdx.x & 63;
    const size_t ro = (size_t)row * D_;
    float v[16];
#pragma unroll
    for (int j = 0; j < 4; ++j) { const float4 x = *(const float4*)(a.base + ro + j * 256 + lane * 4); v[4 * j] = x.x; v[4 * j + 1] = x.y; v[4 * j + 2] = x.z; v[4 * j + 3] = x.w; }
    if (a.add0) {
#pragma unroll
        for (int j = 0; j < 4; ++j) { const uint2 u = *(const uint2*)(a.add0 + ro + j * 256 + lane * 4), w = *(const uint2*)(a.add1 + ro + j * 256 + lane * 4);
            v[4 * j] += lo16(u.x) + lo16(w.x); v[4 * j + 1] += hi16(u.x) + hi16(w.x); v[4 * j + 2] += lo16(u.y) + lo16(w.y); v[4 * j + 3] += hi16(u.y) + hi16(w.y); } }
    if (a.hout) {
#pragma unroll
        for (int j = 0; j < 4; ++j) *(float4*)(a.hout + ro + j * 256 + lane * 4) = make_float4(v[4 * j], v[4 * j + 1], v[4 * j + 2], v[4 * j + 3]); }
    float ss = 0.f;
#pragma unroll
    for (int i = 0; i < 16; ++i) ss += v[i] * v[i];
    ss = wave_sum(ss);
    const float rstd = rsqrtf(ss * (1.f / D_) + 1e-6f);
#pragma unroll
    for (int j = 0; j < 4; ++j) { const float4 gg = *(const float4*)(a.gain + j * 256 + lane * 4); v[4 * j] *= rstd * gg.x; v[4 * j + 1] *= rstd * gg.y; v[4 * j + 2] *= rstd * gg.z; v[4 * j + 3] *= rstd * gg.w; }
    if (a.xn) {
#pragma unroll
        for (int j = 0; j < 4; ++j) { uint2 o; o.x = (unsigned)f2bf(v[4 * j]) | ((unsigned)f2bf(v[4 * j + 1]) << 16); o.y = (unsigned)f2bf(v[4 * j + 2]) | ((unsigned)f2bf(v[4 * j + 3]) << 16);
            *(uint2*)(a.xn + ro + j * 256 + lane * 4) = o; } }
    if (a.fout) {
#pragma unroll
        for (int j = 0; j < 4; ++j) *(float4*)(a.fout + ro + j * 256 + lane * 4) = make_float4(v[4 * j], v[4 * j + 1], v[4 * j + 2], v[4 * j + 3]); }
    for (int c = 0; c < a.naux; ++c) {
        float p = 0.f;
#pragma unroll
        for (int j = 0; j < 4; ++j)
#pragma unroll
            for (int i = 0; i < 4; ++i) p += v[4 * j + i] * a.auxW[(size_t)(j * 256 + lane * 4 + i) * a.auxLd + c];
        p = wave_sum(p);
        if (lane == 0) a.auxOut[(size_t)row * a.naux + c] = a.auxAct ? sigmoidf_(p) : p;
    }
}

struct RouteArgs { const float* h; const float* gain; bf16* xn; const float* wg; const float* bg; const float* we; const float* be; int* cnt; int* list; float* listw; };
__global__ void __launch_bounds__(256) k_route(RouteArgs a) {
    __shared__ float sl[4][20];
    const int w = threadIdx.x >> 6, row = blockIdx.x * 4 + w, lane = threadIdx.x & 63;
    const size_t ro = (size_t)row * D_;
    float v[16];
#pragma unroll
    for (int j = 0; j < 4; ++j) { const float4 x = *(const float4*)(a.h + ro + j * 256 + lane * 4); v[4 * j] = x.x; v[4 * j + 1] = x.y; v[4 * j + 2] = x.z; v[4 * j + 3] = x.w; }
    float ss = 0.f;
#pragma unroll
    for (int i = 0; i < 16; ++i) ss += v[i] * v[i];
    ss = wave_sum(ss);
    const float rstd = rsqrtf(ss * (1.f / D_) + 1e-6f);
#pragma unroll
    for (int j = 0; j < 4; ++j) { const float4 gg = *(const float4*)(a.gain + j * 256 + lane * 4); v[4 * j] *= rstd * gg.x; v[4 * j + 1] *= rstd * gg.y; v[4 * j + 2] *= rstd * gg.z; v[4 * j + 3] *= rstd * gg.w; }
#pragma unroll
    for (int j = 0; j < 4; ++j) { uint2 o; o.x = (unsigned)f2bf(v[4 * j]) | ((unsigned)f2bf(v[4 * j + 1]) << 16); o.y = (unsigned)f2bf(v[4 * j + 2]) | ((unsigned)f2bf(v[4 * j + 3]) << 16);
        *(uint2*)(a.xn + ro + j * 256 + lane * 4) = o; }
    for (int c = 0; c < 20; ++c) {
        float p = 0.f;
#pragma unroll
        for (int j = 0; j < 4; ++j)
#pragma unroll
            for (int i = 0; i < 4; ++i) { const int k = j * 256 + lane * 4 + i; p += v[4 * j + i] * (c < 4 ? a.wg[k * 4 + c] : a.we[k * 16 + (c - 4)]); }
        p = wave_sum(p);
        if (lane == 0) sl[w][c] = p + (c < 4 ? a.bg[c] : a.be[c - 4]);
    }
    if (lane == 0) {
        volatile float* L = sl[w];
        int gt = 0; float gm = L[0];
        for (int j = 1; j < 4; ++j) if (L[j] > gm) { gm = L[j]; gt = j; }
        float den = 0.f; for (int j = 0; j < 4; ++j) den += __expf(L[j] - gm);
        const float gw = 1.f / den;
        int i0 = 0; float v0 = L[4 + gt * 4];
        for (int j = 1; j < 4; ++j) { const float x = L[4 + gt * 4 + j]; if (x > v0) { v0 = x; i0 = j; } }
        int i1 = -1; float v1 = 0.f;
        for (int j = 0; j < 4; ++j) { if (j == i0) continue; const float x = L[4 + gt * 4 + j]; if (i1 < 0 || x > v1) { v1 = x; i1 = j; } }
        const float e = __expf(v1 - v0), w0 = gw / (1.f + e), w1 = gw * e / (1.f + e);
        const int e0 = gt * 4 + i0, e1 = gt * 4 + i1;
        int p0 = atomicAdd(&a.cnt[e0], 1); a.list[e0 * T_ + p0] = (row << 1); a.listw[e0 * T_ + p0] = w0;
        int p1 = atomicAdd(&a.cnt[e1], 1); a.list[e1 * T_ + p1] = (row << 1) | 1; a.listw[e1 * T_ + p1] = w1;
    }
}
__global__ void k_moe_offsets(const int* cnt, int* eb) { if (threadIdx.x == 0) { int acc = 0; for (int e = 0; e < 16; ++e) { eb[e] = acc; acc += (cnt[e] + 255) & ~255; } } }

__global__ void __launch_bounds__(256) k_conv_silu(const bf16* qkraw, const float* cw, bf16* qm, bf16* km) {
    const size_t idx = (size_t)blockIdx.x * 256 + threadIdx.x; const int m = (int)(idx >> 10), c = (int)(idx & 1023), b = m >> 11, s = m & 2047;
    float acc = 0.f;
#pragma unroll
    for (int j = 0; j < 4; ++j) { const int ss = s - 3 + j; if (ss >= 0) acc += cw[j * 1024 + c] * bf2f(qkraw[(size_t)(m - 3 + j) * 1024 + c]); }
    const float y = acc * sigmoidf_(acc);
    const int cc = c & 511, hh = cc >> 7, d = cc & 127;
    (c < 512 ? qm : km)[((size_t)(b * 4 + hh) * 2048 + s) * 128 + d] = f2bf(y);
}
__global__ void k_gates(const float* ifr, const float* gb, float* li, float* bc) {
    const int bh = blockIdx.x * blockDim.x + threadIdx.x; if (bh >= 32) return; const int b = bh >> 2, h = bh & 3;
    float run = 0.f;
    for (int s = 0; s < 2048; ++s) { const size_t m = (size_t)b * 2048 + s;
        const float pi = 15.f * tanhf((ifr[m * 8 + h] + gb[h]) * (1.f / 15.f)), pf = 15.f * tanhf((ifr[m * 8 + 4 + h] + gb[4 + h]) * (1.f / 15.f));
        const float lf = -log1pf(__expf(-pf));
        run += lf; li[bh * 2048 + s] = pi; bc[bh * 2048 + s] = run; }
}
__global__ void __launch_bounds__(256) k_rotary(const bf16* src, bf16* dst, int nrows) {
    const size_t idx = (size_t)blockIdx.x * 256 + threadIdx.x; const size_t r = idx >> 6; const int i = (int)(idx & 63); if (r >= (size_t)nrows) return;
    const int pos = (int)(r & 2047);
    const float inv = powf(10000.f, -(float)i * (1.f / 64.f)), ang = (float)pos * inv; float sn, cs; sincosf(ang, &sn, &cs);
    const float x1 = bf2f(src[r * 128 + i]), x2 = bf2f(src[r * 128 + 64 + i]);
    dst[r * 128 + i] = f2bf(x1 * cs - x2 * sn); dst[r * 128 + 64 + i] = f2bf(x2 * cs + x1 * sn);
}
__global__ void __launch_bounds__(128) k_kmean(const bf16* kb, float* kmean) {
    const int bhn = blockIdx.x, d = threadIdx.x; const bf16* p = kb + (size_t)bhn * 256 * 128 + d;
    float s = 0.f; for (int j = 0; j < 256; ++j) s += bf2f(p[(size_t)j * 128]);
    kmean[bhn * 128 + d] = s * (1.f / 256.f);
}

__device__ __forceinline__ float dot_qk(const float* qs, const bf16* krow) {
    float acc = 0.f;
#pragma unroll
    for (int i = 0; i < 16; ++i) { const uint4 u = ((const uint4*)krow)[i];
        acc += qs[8 * i] * lo16(u.x) + qs[8 * i + 1] * hi16(u.x) + qs[8 * i + 2] * lo16(u.y) + qs[8 * i + 3] * hi16(u.y) + qs[8 * i + 4] * lo16(u.z) + qs[8 * i + 5] * hi16(u.z) + qs[8 * i + 6] * lo16(u.w) + qs[8 * i + 7] * hi16(u.w); }
    return acc;
}
__device__ __forceinline__ void pv_accum(float& a0, float& a1, float p, const bf16* v0, const bf16* v1) {
#pragma unroll
    for (int i = 0; i < 8; ++i) { const uint4 u = ((const uint4*)v0)[i], w = ((const uint4*)v1)[i];
        const float p0 = __shfl(p, 8 * i), p1 = __shfl(p, 8 * i + 1), p2 = __shfl(p, 8 * i + 2), p3 = __shfl(p, 8 * i + 3), p4 = __shfl(p, 8 * i + 4), p5 = __shfl(p, 8 * i + 5), p6 = __shfl(p, 8 * i + 6), p7 = __shfl(p, 8 * i + 7);
        a0 += p0 * lo16(u.x) + p1 * hi16(u.x) + p2 * lo16(u.y) + p3 * hi16(u.y) + p4 * lo16(u.z) + p5 * hi16(u.z) + p6 * lo16(u.w) + p7 * hi16(u.w);
        a1 += p0 * lo16(w.x) + p1 * hi16(w.x) + p2 * lo16(w.y) + p3 * hi16(w.y) + p4 * lo16(w.z) + p5 * hi16(w.z) + p6 * lo16(w.w) + p7 * hi16(w.w); }
}
__device__ __forceinline__ void osm_step(float sc, bool valid, float& mrun, float& lrun, float& a0, float& a1, const bf16* v0, const bf16* v1) {
    const float cm = wave_max(valid ? sc : -3e38f);
    if (cm < -1e38f) return;
    const float mn = fmaxf(mrun, cm), alpha = __expf(mrun - mn);
    const float p = valid ? __expf(sc - mn) : 0.f;
    lrun = lrun * alpha + wave_sum(p); a0 *= alpha; a1 *= alpha; mrun = mn;
    pv_accum(a0, a1, p, v0, v1);
}

__global__ void __launch_bounds__(256) k_mlstm_naive(const bf16* QM, const bf16* KM, const bf16* VMT, const float* LI, const float* BC, const bf16* OM, const float* gain, bf16* Y0) {
    __shared__ float qs[4][128];
    const int w = threadIdx.x >> 6, lane = threadIdx.x & 63, gid = blockIdx.x * 4 + w, t = gid & 2047, bh = gid >> 11;
    const bf16* qrow = QM + ((size_t)bh * 2048 + t) * 128;
    const float scale = 0.08838834764831845f;
    qs[w][2 * lane] = bf2f(qrow[2 * lane]) * scale; qs[w][2 * lane + 1] = bf2f(qrow[2 * lane + 1]) * scale;
    __syncthreads();
    const float bt = BC[bh * 2048 + t];
    float n0 = 0.f, n1 = 0.f, den = 0.f;
    const bf16* v0 = VMT + ((size_t)bh * 128 + 2 * lane) * 2048; const bf16* v1 = v0 + 2048;
    for (int c = 0; c <= (t >> 6); ++c) {
        const int s = c * 64 + lane; float p = 0.f;
        if (s <= t) { const float d = dot_qk(qs[w], KM + ((size_t)bh * 2048 + s) * 128); p = d * __expf(bt - BC[bh * 2048 + s] + LI[bh * 2048 + s]); }
        den += p;
        pv_accum(n0, n1, p, v0 + c * 64, v1 + c * 64);
    }
    den = wave_sum(den);
    const float dn = fmaxf(fabsf(den), 1.f), h0 = n0 / dn, h1 = n1 / dn;
    const float ms = wave_sum(h0 * h0 + h1 * h1) * (1.f / 128.f), r = rsqrtf(ms + 1e-6f);
    const int b = bh >> 2, h = bh & 3, col = h * 128 + 2 * lane; const size_t m = (size_t)b * 2048 + t;
    const float y0 = h0 * r * gain[col] * sigmoidf_(bf2f(OM[m * 512 + col])), y1 = h1 * r * gain[col + 1] * sigmoidf_(bf2f(OM[m * 512 + col + 1]));
    *(unsigned*)(Y0 + m * 1024 + col) = (unsigned)f2bf(y0) | ((unsigned)f2bf(y1) << 16);
}

__global__ void __launch_bounds__(256) k_moba_naive(const bf16* QB, const bf16* KB, const bf16* VBT, const float* KMEAN, bf16* Y0) {
    __shared__ float qs[4][128];
    const int w = threadIdx.x >> 6, lane = threadIdx.x & 63, gid = blockIdx.x * 4 + w, t = gid & 2047, bh = gid >> 11;
    const bf16* qrow = QB + ((size_t)bh * 2048 + t) * 128;
    qs[w][2 * lane] = bf2f(qrow[2 * lane]); qs[w][2 * lane + 1] = bf2f(qrow[2 * lane + 1]);
    __syncthreads();
    const int cur = t >> 8;
    float gv = NEGINF;
    if (lane < 8 && lane < cur) { const float* km = KMEAN + ((size_t)bh * 8 + lane) * 128; float a = 0.f; for (int d = 0; d < 128; ++d) a += qs[w][d] * km[d]; gv = a; }
    unsigned selmask = 0u; float gcur = (lane < 8) ? gv : -3e38f;
    for (int r = 0; r < 3; ++r) {
        const float mx = wave_max(gcur);
        const unsigned long long bal = __ballot(gcur == mx);
        const int win = __ffsll((long long)bal) - 1;
        if (mx > 0.5f * NEGINF) selmask |= 1u << win;
        if (lane == win) gcur = -3e38f;
    }
    const float scale = 0.08838834764831845f;
    float mrun = -3e38f, lrun = 0.f, a0 = 0.f, a1 = 0.f;
    const bf16* v0 = VBT + ((size_t)bh * 128 + 2 * lane) * 2048; const bf16* v1 = v0 + 2048;
    for (int n = 0; n <= cur; ++n) {
        if (n != cur && !((selmask >> n) & 1u)) continue;
        for (int c = 0; c < 4; ++c) {
            const int s = n * 256 + c * 64 + lane;
            if (n * 256 + c * 64 > t) break;
            const bool valid = s <= t;
            float sc = 0.f; if (valid) sc = dot_qk(qs[w], KB + ((size_t)bh * 2048 + s) * 128) * scale;
            osm_step(sc, valid, mrun, lrun, a0, a1, v0 + n * 256 + c * 64, v1 + n * 256 + c * 64);
        }
    }
    const float inv = 1.f / fmaxf(lrun, 1e-30f);
    const int b = bh >> 2, h = bh & 3, col = 512 + h * 128 + 2 * lane; const size_t m = (size_t)b * 2048 + t;
    *(unsigned*)(Y0 + m * 1024 + col) = (unsigned)f2bf(a0 * inv) | ((unsigned)f2bf(a1 * inv) << 16);
}

__global__ void __launch_bounds__(256) k_nsa_cmp_naive(const bf16* Q1, const bf16* KCMP, const bf16* VCMPT, bf16* OC, unsigned* SELM) {
    __shared__ float qs[4][128];
    __shared__ float ps[4][128];
    const int w = threadIdx.x >> 6, lane = threadIdx.x & 63, gid = blockIdx.x * 4 + w, s = gid & 2047, bg = gid >> 11, b = bg >> 1, g = bg & 1;
    const float scale = 0.08838834764831845f;
    float imp0 = 0.f, imp1 = 0.f;
    volatile float* Q = qs[w]; volatile float* P = ps[w];
    for (int r = 0; r < 4; ++r) {
        const bf16* qrow = Q1 + ((size_t)(b * 8 + g * 4 + r) * 2048 + s) * 128;
        Q[2 * lane] = bf2f(qrow[2 * lane]); Q[2 * lane + 1] = bf2f(qrow[2 * lane + 1]);
        const int n0 = lane, n1 = lane + 64;
        const bool ok0 = (16 * n0 + 31) <= s, ok1 = (n1 < 127) && ((16 * n1 + 31) <= s);
        float s0 = 0.f, s1 = 0.f;
        if (ok0) s0 = dot_qk((const float*)qs[w], KCMP + ((size_t)bg * 128 + n0) * 128) * scale;
        if (ok1) s1 = dot_qk((const float*)qs[w], KCMP + ((size_t)bg * 128 + n1) * 128) * scale;
        const float mx = wave_max(fmaxf(ok0 ? s0 : -3e38f, ok1 ? s1 : -3e38f));
        const float p0 = ok0 ? __expf(s0 - mx) : 0.f, p1 = ok1 ? __expf(s1 - mx) : 0.f;
        const float sum = wave_sum(p0 + p1), inv = 1.f / fmaxf(sum, 1e-30f);
        const float q0 = p0 * inv, q1 = p1 * inv;
        imp0 += q0; imp1 += q1;
        P[n0] = q0; P[n1] = q1;
        float a0 = 0.f, a1 = 0.f;
        const bf16* v0 = VCMPT + ((size_t)bg * 128 + 2 * lane) * 128; const bf16* v1 = v0 + 128;
        for (int n = 0; n < 127; ++n) { const float p = P[n]; a0 += p * bf2f(v0[n]); a1 += p * bf2f(v1[n]); }
        const size_t m = (size_t)b * 2048 + s; const int col = (g * 4 + r) * 128 + 2 * lane;
        *(unsigned*)(OC + m * 1024 + col) = (unsigned)f2bf(a0) | ((unsigned)f2bf(a1) << 16);
    }
    P[lane] = imp0; P[lane + 64] = imp1;
    const int cur = s >> 6;
    float val = -3e38f;
    if (lane < 32) { const int j = lane; float im = 0.f;
        for (int n = 4 * j - 1; n <= 4 * j + 3; ++n) if (n >= 0 && n < 127) im += P[n];
        const bool forced = (j == 0) || (j == cur) || (j == cur - 1);
        val = (j <= cur) ? (forced ? 1e4f : im) : NEGINF; }
    unsigned mask = 0u;
    for (int r = 0; r < 8; ++r) {
        const float mx = wave_max(val);
        const unsigned long long bal = __ballot(val == mx);
        const int win = __ffsll((long long)bal) - 1;
        if (mx > 0.5f * NEGINF) mask |= 1u << win;
        if (lane == win) val = -3e38f;
    }
    if (lane == 0) SELM[bg * 2048 + s] = mask;
}

__global__ void __launch_bounds__(256) k_nsa_selwin_naive(const bf16* Q1R, const bf16* KS, const bf16* VST, const bf16* KW, const bf16* VWT, const bf16* OC, const unsigned* SELM, const float* G, bf16* Y1) {
    __shared__ float qs[4][128];
    const int w = threadIdx.x >> 6, lane = threadIdx.x & 63, gid = blockIdx.x * 4 + w, s = gid & 2047, bh = gid >> 11, b = bh >> 3, hd = bh & 7, bg = b * 2 + (hd >> 2);
    const bf16* qrow = Q1R + ((size_t)bh * 2048 + s) * 128;
    qs[w][2 * lane] = bf2f(qrow[2 * lane]); qs[w][2 * lane + 1] = bf2f(qrow[2 * lane + 1]);
    __syncthreads();
    const float scale = 0.08838834764831845f;
    const unsigned mask = SELM[bg * 2048 + s];
    const int cur = s >> 6;
    float os0, os1, ow0, ow1;
    {   float mrun = -3e38f, lrun = 0.f, a0 = 0.f, a1 = 0.f;
        const bf16* v0 = VST + ((size_t)bg * 128 + 2 * lane) * 2048; const bf16* v1 = v0 + 2048;
        for (int j = 0; j <= cur; ++j) { if (!((mask >> j) & 1u)) continue;
            const int k = j * 64 + lane; const bool valid = k <= s;
            float sc = 0.f; if (valid) sc = dot_qk(qs[w], KS + ((size_t)bg * 2048 + k) * 128) * scale;
            osm_step(sc, valid, mrun, lrun, a0, a1, v0 + j * 64, v1 + j * 64); }
        const float inv = 1.f / fmaxf(lrun, 1e-30f); os0 = a0 * inv; os1 = a1 * inv; }
    {   float mrun = -3e38f, lrun = 0.f, a0 = 0.f, a1 = 0.f;
        const bf16* v0 = VWT + ((size_t)bg * 128 + 2 * lane) * 2048; const bf16* v1 = v0 + 2048;
        for (int j = (cur >= 8 ? cur - 8 : 0); j <= cur; ++j) {
            const int k = j * 64 + lane; const bool valid = (k <= s) && (s - k < 512);
            float sc = 0.f; if (valid) sc = dot_qk(qs[w], KW + ((size_t)bg * 2048 + k) * 128) * scale;
            osm_step(sc, valid, mrun, lrun, a0, a1, v0 + j * 64, v1 + j * 64); }
        const float inv = 1.f / fmaxf(lrun, 1e-30f); ow0 = a0 * inv; ow1 = a1 * inv; }
    const size_t m = (size_t)b * 2048 + s; const int col = hd * 128 + 2 * lane;
    const float g0 = G[m * 24 + hd * 3], g1 = G[m * 24 + hd * 3 + 1], g2 = G[m * 24 + hd * 3 + 2];
    const unsigned oc = *(const unsigned*)(OC + m * 1024 + col);
    const float y0 = g0 * lo16(oc) + g1 * os0 + g2 * ow0, y1 = g0 * hi16(oc) + g1 * os1 + g2 * ow1;
    *(unsigned*)(Y1 + m * 1024 + col) = (unsigned)f2bf(y0) | ((unsigned)f2bf(y1) << 16);
}

template <class G, bool DUAL> static void launch_gemm(const G& g, int mt, int nt, int z, hipStream_t st) { hipLaunchKernelGGL((k_gemm_naive<G, DUAL>), dim3(mt, nt, z), dim3(256), 0, st, g); }

extern "C" void kernel_launch(void* const* d_in, const int* in_sizes, int n_in, void* d_out, int out_size, void* d_ws, size_t ws_size, hipStream_t stream) {
    (void)in_sizes; (void)n_in; (void)out_size; (void)ws_size;
    const float* const* in = (const float* const*)d_in;
    unsigned char* ws = (unsigned char*)d_ws;
    float* hbuf = (float*)d_out;
    int* ctl = (int*)(ws + WS_CTL);
    (void)hipMemsetAsync(ws + WS_CTL, 0, 64 * 1024, stream);
    bf16* XN = (bf16*)(ws + WS_R0);
    unsigned char* sm = ws + WS_SM;
    float* IFr = (float*)(sm + SM_IF); float* LI = (float*)(sm + SM_LI); float* BC = (float*)(sm + SM_BC); float* KMEAN = (float*)(sm + SM_KMEAN);
    int* LIST = (int*)(sm + SM_LIST); float* LISTW = (float*)(sm + SM_LISTW); unsigned* SELM = (unsigned*)(sm + SM_SELM); float* Gt = (float*)(sm + SM_G);
    bf16* HC = (bf16*)(sm + SM_HC); bf16* KCMP = (bf16*)(sm + SM_KCMP); bf16* VCMPT = (bf16*)(sm + SM_VCMPT);
    {   RowNormArgs a{}; a.base = in[0]; a.gain = in[1]; a.xn = XN; a.auxW = in[2] + 2048; a.auxLd = 3592; a.naux = 8; a.auxAct = 0; a.auxOut = IFr;
        hipLaunchKernelGGL(k_rownorm, dim3(T_ / 4), dim3(256), 0, stream, a); }
    bf16* QKraw = (bf16*)(ws + WS_R1); bf16* OM = (bf16*)(ws + WS_R2); bf16* QB = (bf16*)(ws + WS_R2 + 16 * MiB);
    bf16* KB = (bf16*)(ws + WS_R3); bf16* VMT = (bf16*)(ws + WS_R3 + 16 * MiB); bf16* VBT = (bf16*)(ws + WS_R4);
    {   GProj0 g{}; g.xn = XN; g.w = in[2]; g.qkraw = QKraw; g.vmt = VMT; g.om = OM; g.qb = QB; g.kb = KB; g.vbt = VBT; g.abias = nullptr; g.N = 3592; g.K = 1024; g.ldw = 3592;
        launch_gemm<GProj0, false>(g, T_ / 64, (3592 + 63) / 64, 1, stream); }
    bf16* QM = (bf16*)(ws + WS_R0); bf16* KM = (bf16*)(ws + WS_R0 + 16 * MiB);
    hipLaunchKernelGGL(k_conv_silu, dim3(T_ * 1024 / 256), dim3(256), 0, stream, QKraw, in[3], QM, KM);
    hipLaunchKernelGGL(k_gates, dim3(1), dim3(64), 0, stream, IFr, in[4], LI, BC);
    hipLaunchKernelGGL(k_rotary, dim3(T_ * 4 * 64 / 256), dim3(256), 0, stream, QB, QB, T_ * 4);
    hipLaunchKernelGGL(k_rotary, dim3(T_ * 4 * 64 / 256), dim3(256), 0, stream, KB, KB, T_ * 4);
    hipLaunchKernelGGL(k_kmean, dim3(32 * 8), dim3(128), 0, stream, KB, KMEAN);
    bf16* Y0 = (bf16*)(ws + WS_R1);
    hipLaunchKernelGGL(k_mlstm_naive, dim3(32 * 2048 / 4), dim3(256), 0, stream, QM, KM, VMT, LI, BC, OM, in[5], Y0);
    hipLaunchKernelGGL(k_moba_naive, dim3(32 * 2048 / 4), dim3(256), 0, stream, QB, KB, VBT, KMEAN, Y0);
    {   GOut g{}; g.y = Y0; g.w = in[6]; g.hin = in[0]; g.hout = hbuf; g.abias = nullptr; g.N = 1024; g.K = 1024; g.ldw = 1024;
        launch_gemm<GOut, false>(g, T_ / 64, 16, 1, stream); }
    for (int layer = 0; layer < 2; ++layer) {
        if (layer == 1) {
            bf16* Q1 = (bf16*)(ws + WS_R1); bf16* Q1R = (bf16*)(ws + WS_R2); bf16* OC = (bf16*)(ws + WS_R3);
            bf16* KC = (bf16*)(ws + WS_R4); bf16* VC = (bf16*)(ws + WS_R4 + 8 * MiB); bf16* KS = (bf16*)(ws + WS_R4 + 16 * MiB); bf16* KW = (bf16*)(ws + WS_R4 + 24 * MiB);
            bf16* VST = (bf16*)(ws + WS_R5); bf16* VWT = (bf16*)(ws + WS_R5 + 8 * MiB);
            {   GProj1 g{}; g.xn = XN; g.w = in[16]; g.q1 = Q1; g.kc = KC; g.vc = VC; g.ks = KS; g.vst = VST; g.kw = KW; g.vwt = VWT; g.abias = nullptr; g.N = 2584; g.K = 1024; g.ldw = 2584;
                launch_gemm<GProj1, false>(g, T_ / 64, (2584 + 63) / 64, 1, stream); }
            hipLaunchKernelGGL(k_rotary, dim3(T_ * 8 * 64 / 256), dim3(256), 0, stream, Q1, Q1R, T_ * 8);
            hipLaunchKernelGGL(k_rotary, dim3(T_ * 2 * 64 / 256), dim3(256), 0, stream, KS, KS, T_ * 2);
            hipLaunchKernelGGL(k_rotary, dim3(T_ * 2 * 64 / 256), dim3(256), 0, stream, KW, KW, T_ * 2);
            {   GCmp1 g{}; g.kc = KC; g.vc = VC; g.wk1 = in[18]; g.wv1 = in[20]; g.pe = in[17]; g.hc = HC; g.abias = nullptr; g.N = 256; g.K = 4096; g.ldw = 256;
                GCmp1 gk = g; gk.abias = in[17];
                hipLaunchKernelGGL((k_gemm_naive<GCmp1, false>), dim3(2048 / 64, 4, 1), dim3(256), 0, stream, gk);
                GCmp1 gv = g; gv.abias = in[17] + 4096; gv.kc = VC; gv.wk1 = in[20]; gv.hc = HC + (size_t)2048 * 256;
                hipLaunchKernelGGL((k_gemm_naive<GCmp1, false>), dim3(2048 / 64, 4, 1), dim3(256), 0, stream, gv); }
            {   GCmp2 g{}; g.hc = HC; g.wk2 = in[19]; g.wv2 = in[21]; g.kcmp = KCMP; g.vcmpt = VCMPT; g.abias = nullptr; g.N = 128; g.K = 256; g.ldw = 128;
                launch_gemm<GCmp2, false>(g, 2048 / 64, 2, 2, stream); }
            hipLaunchKernelGGL(k_nsa_cmp_naive, dim3(16 * 2048 / 4), dim3(256), 0, stream, Q1, KCMP, VCMPT, OC, SELM);
            bf16* Y1 = (bf16*)(ws + WS_R0);
            hipLaunchKernelGGL(k_nsa_selwin_naive, dim3(64 * 2048 / 4), dim3(256), 0, stream, Q1R, KS, VST, KW, VWT, OC, SELM, Gt, Y1);
            {   GOut g{}; g.y = Y1; g.w = in[22]; g.hin = hbuf; g.hout = hbuf; g.abias = nullptr; g.N = 1024; g.K = 1024; g.ldw = 1024;
                launch_gemm<GOut, false>(g, T_ / 64, 16, 1, stream); }
        }
        const int ib = layer == 0 ? 7 : 23;
        int* cnt = ctl + CW_CNT + 16 * layer; int* eb = ctl + CW_EB + 16 * layer;
        bf16* H = (bf16*)(ws + WS_R1); bf16* YS0 = (bf16*)(ws + WS_R2); bf16* YS1 = (bf16*)(ws + WS_R3);
        {   RouteArgs a{}; a.h = hbuf; a.gain = in[ib]; a.xn = XN; a.wg = in[ib + 1]; a.bg = in[ib + 2]; a.we = in[ib + 3]; a.be = in[ib + 4]; a.cnt = cnt; a.list = LIST; a.listw = LISTW;
            hipLaunchKernelGGL(k_route, dim3(T_ / 4), dim3(256), 0, stream, a); }
        hipLaunchKernelGGL(k_moe_offsets, dim3(1), dim3(64), 0, stream, cnt, eb);
        {   GMoe1 g{}; g.xn = XN; g.w1 = in[ib + 5]; g.w3 = in[ib + 6]; g.cnt = cnt; g.eb = eb; g.list = LIST; g.H = H; g.abias = nullptr; g.N = 256; g.K = 1024; g.ldw = 256;
            launch_gemm<GMoe1, true>(g, T_ / 64, 4, 16, stream); }
        {   GMoe2 g{}; g.H = H; g.w2 = in[ib + 7]; g.cnt = cnt; g.eb = eb; g.list = LIST; g.listw = LISTW; g.ys0 = YS0; g.ys1 = YS1; g.abias = nullptr; g.N = 1024; g.K = 256; g.ldw = 1024;
            launch_gemm<GMoe2, false>(g, T_ / 64, 16, 16, stream); }
        if (layer == 0) {
            RowNormArgs a{}; a.base = hbuf; a.add0 = YS0; a.add1 = YS1; a.hout = hbuf; a.gain = in[15]; a.xn = XN; a.auxW = in[16] + 2560; a.auxLd = 2584; a.naux = 24; a.auxAct = 1; a.auxOut = Gt;
            hipLaunchKernelGGL(k_rownorm, dim3(T_ / 4), dim3(256), 0, stream, a);
        } else {
            RowNormArgs a{}; a.base = hbuf; a.add0 = YS0; a.add1 = YS1; a.gain = in[31]; a.fout = hbuf;
            hipLaunchKernelGGL(k_rownorm, dim3(T_ / 4), dim3(256), 0, stream, a);
        }
    }
}
```

```cpp
#include <hip/hip_runtime.h>
#include <stdint.h>
#include <math.h>
#include <stdio.h>

#define T_ 16384
#define S_ 2048
#define D_ 1024
#define NEGINF (-1e30f)

typedef unsigned short bf16;
__device__ __forceinline__ float bf2f(bf16 v) { return __uint_as_float(((unsigned)v) << 16); }
__device__ __forceinline__ bf16 f2bf(float f) { unsigned u = __float_as_uint(f); return (bf16)((u + 0x7fffu + ((u >> 16) & 1u)) >> 16); }
__device__ __forceinline__ unsigned pk2(float lo, float hi) { unsigned r; asm("v_cvt_pk_bf16_f32 %0, %1, %2" : "=v"(r) : "v"(lo), "v"(hi)); return r; }
__device__ __forceinline__ float lo16(unsigned u) { return __uint_as_float(u << 16); }
__device__ __forceinline__ float hi16(unsigned u) { return __uint_as_float(u & 0xffff0000u); }
template <int CTRL> __device__ __forceinline__ float dpp_mov(float x) { return __builtin_bit_cast(float, __builtin_amdgcn_update_dpp(0, __builtin_bit_cast(int, x), CTRL, 0xF, 0xF, true)); }
__device__ __forceinline__ float row16_sum(float v) { v += dpp_mov<0x128>(v); v += dpp_mov<0x124>(v); v += dpp_mov<0x122>(v); v += dpp_mov<0x121>(v); return v; }
__device__ __forceinline__ float pair32(float a, float b) { const auto r = __builtin_amdgcn_permlane32_swap(__float_as_uint(a), __float_as_uint(b), false, false); return __uint_as_float(r[0]) + __uint_as_float(r[1]); }
__device__ __forceinline__ float pair16(float a, float b) { const auto r = __builtin_amdgcn_permlane16_swap(__float_as_uint(a), __float_as_uint(b), false, false); return __uint_as_float(r[0]) + __uint_as_float(r[1]); }
__device__ __forceinline__ float wave_sum(float v) { v = row16_sum(v); v = pair16(v, v); return pair32(v, v); }
__device__ __forceinline__ float wave_max(float v) {
#pragma unroll
    for (int o = 32; o > 0; o >>= 1) v = fmaxf(v, __shfl_xor(v, o));
    return v; }
__device__ __forceinline__ float sigmoidf_(float x) { return __builtin_amdgcn_rcpf(1.f + __expf(-x)); }

constexpr size_t MiB = 1ull << 20;
constexpr size_t WS_CTL = 0;
constexpr size_t WS_WB = 256 * 1024;
constexpr size_t WS_R0 = 69 * MiB;
constexpr size_t WS_R1 = 101 * MiB;
constexpr size_t WS_R2 = 133 * MiB;
constexpr size_t WS_R3 = 165 * MiB;
constexpr size_t WS_R4 = 197 * MiB;
constexpr size_t WS_R5 = 229 * MiB;
constexpr size_t WS_SM = 245 * MiB;
constexpr size_t SM_IF = 0;
constexpr size_t SM_LI = SM_IF + 512 * 1024;
constexpr size_t SM_BC = SM_LI + 256 * 1024;
constexpr size_t SM_KMEAN = SM_BC + 256 * 1024;
constexpr size_t SM_LIST = SM_KMEAN + 128 * 1024;
constexpr size_t SM_LISTW = SM_LIST + 1 * MiB;
constexpr size_t SM_SELM = SM_LISTW + 1 * MiB;
constexpr size_t SM_G = SM_SELM + 128 * 1024;
constexpr size_t SM_HC = SM_G + 1536 * 1024;
constexpr size_t SM_KCMP = SM_HC + 2 * MiB;
constexpr size_t SM_VCMPT = SM_KCMP + 512 * 1024;
constexpr size_t SM_ROT = SM_VCMPT + 512 * 1024;
constexpr size_t SM_CB = SM_ROT + 1 * MiB;
constexpr size_t SM_LISTR = SM_CB + 4096;
constexpr size_t SM_END = SM_LISTR + 1 * MiB;
static_assert(SM_END <= 11 * MiB, "small region");
static_assert(WS_R3 - WS_R2 == (size_t)T_ * 1024 * 2, "YS slot 1 directly follows YS slot 0");
constexpr int CW_CNT = 1024;
constexpr int CW_BAR = 4096;
constexpr int CW_DONE = 8192;
constexpr size_t CTL_ZERO_BYTES = 128 * 1024;

constexpr int LDS_BYTES = 147456;
constexpr int LDSCTL_OFF = 143360;
constexpr int MISC_OFF = LDSCTL_OFF + 320;

#define LAS __attribute__((address_space(3)))
#define XB_TMO      128
#define XB_XCNT(j)  (256  + 64 * (j))
#define XB_XSUB(j)  (1280 + 64 * (j))
#define XB_XGEN(j)  (2304 + 64 * (j))
#define XB_TOP      3328
#define XB_TOPGEN   3392
#define XCD_BAR_WORDS 3456
#define XB_SPIN_CAP (1u << 22)
__device__ __forceinline__ unsigned xb_ld(unsigned* p)              { return __hip_atomic_load(p, __ATOMIC_RELAXED, __HIP_MEMORY_SCOPE_AGENT); }
__device__ __forceinline__ unsigned xb_add(unsigned* p, unsigned v) { return __hip_atomic_fetch_add(p, v, __ATOMIC_RELAXED, __HIP_MEMORY_SCOPE_AGENT); }
__device__ __forceinline__ unsigned xb_xcc_id() { return (unsigned)__builtin_amdgcn_s_getreg((3 << 11) | 20) & 0xFu; }
#define XB_SPIN(cond, bar) do { unsigned _sp = 0; while (cond) { __builtin_amdgcn_s_sleep(1); \
    if ((++_sp & 255u) == 0u) { if (xb_ld(&(bar)[XB_TMO])) break; if (_sp > XB_SPIN_CAP) { atomicAdd(&(bar)[XB_TMO], 1u); break; } } } } while (0)
struct XcdBarrier { unsigned* bar; unsigned x; volatile LAS unsigned* st; };
__device__ __forceinline__ XcdBarrier xcd_barrier_post(unsigned* bar, volatile LAS unsigned* st) {
    XcdBarrier b; b.bar = bar; b.x = xb_xcc_id(); b.st = st;
    if (threadIdx.x == 0) (void)xb_add(&bar[XB_XCNT(b.x)], 1u);
    return b;
}
__device__ __forceinline__ void xcd_barrier_complete(unsigned* bar, unsigned x, unsigned& nloc, unsigned& nx) {
    const unsigned G = gridDim.x * gridDim.y * gridDim.z;
    unsigned sum, cnt, mine, sp = 0u;
    for (;;) {
        sum = 0u; cnt = 0u; mine = 0u;
#pragma unroll
        for (unsigned j = 0; j < 16; ++j) { const unsigned c = xb_ld(&bar[XB_XCNT(j)]); sum += c; cnt += (c > 0u) ? 1u : 0u; mine = (j == x) ? c : mine; }
        if (sum == G) break;
        __builtin_amdgcn_s_sleep(1);
        if ((++sp & 255u) == 0u) { if (xb_ld(&bar[XB_TMO])) break; if (sp > XB_SPIN_CAP) { atomicAdd(&bar[XB_TMO], 1u); break; } }
    }
    nloc = mine > 0u ? mine : 1u; nx = cnt > 0u ? cnt : 1u;
}
__device__ __forceinline__ void xcd_barrier(const XcdBarrier& b) {
    asm volatile("s_waitcnt vmcnt(0)" ::: "memory");
    __syncthreads();
    if (threadIdx.x == 0) {
        unsigned* bar = b.bar;
        __builtin_amdgcn_s_waitcnt(0);
        unsigned nloc = b.st[0], nx = b.st[1];
        if (nloc == 0u) { xcd_barrier_complete(bar, b.x, nloc, nx); b.st[0] = nloc; b.st[1] = nx; }
        const unsigned gen = b.st[2]; b.st[2] = gen + 1u;
        const unsigned old = xb_add(&bar[XB_XSUB(b.x)], 1u);
        if (old + 1u == (gen + 1u) * nloc) {
            __builtin_amdgcn_fence(__ATOMIC_RELEASE, "agent");
            asm volatile("s_waitcnt vmcnt(0)" ::: "memory");
            const unsigned og = xb_add(&bar[XB_TOP], 1u);
            if (og + 1u == (gen + 1u) * nx) {
#pragma unroll
                for (unsigned j = 0; j < 16; ++j) (void)xb_add(&bar[XB_XGEN(j)], 1u);
            } else XB_SPIN(xb_ld(&bar[XB_XGEN(b.x)]) == gen, bar);
            __builtin_amdgcn_fence(__ATOMIC_ACQUIRE, "agent");
            asm volatile("s_waitcnt vmcnt(0)" ::: "memory");
        } else {
            XB_SPIN(xb_ld(&bar[XB_XGEN(b.x)]) == gen, bar);
            __builtin_amdgcn_fence(__ATOMIC_ACQUIRE, "agent");
            asm volatile("s_waitcnt vmcnt(0)" ::: "memory");
        }
    }
    __syncthreads();
}

template <class G, bool DUAL>
__device__ __forceinline__ void gemm_tile_naive(const G& g, int z, int tile_m, int tile_n, bool active, int tid, float* ldsh) {
    float (*As)[68] = (float (*)[68])ldsh;
    float (*Ws)[16][68] = (float (*)[16][68])(ldsh + 16 * 68);
    const int M = active ? g.M(z) : 0;
    const int tx = tid & 15, ty = tid >> 4;
    float acc[4][4], acc2[4][4];
#pragma unroll
    for (int i = 0; i < 4; ++i)
#pragma unroll
        for (int j = 0; j < 4; ++j) { acc[i][j] = 0.f; acc2[i][j] = 0.f; }
    const int ar = tid >> 2, ak = (tid & 3) * 4;
    const int wk = tid >> 4, wn = (tid & 15) * 4;
    const float* Wp = g.W(z);
    const float* Wp2 = DUAL ? g.W2(z) : nullptr;
    const bool wok = active && (tile_n + wn) < g.N;
    for (int k0 = 0; k0 < g.K; k0 += 16) {
        float a4[4] = {0.f, 0.f, 0.f, 0.f};
        if (tile_m + ar < M) g.aload(z, tile_m + ar, k0 + ak, a4);
        float4 w4 = make_float4(0.f, 0.f, 0.f, 0.f), w42 = w4;
        if (wok) { w4 = *(const float4*)(Wp + (size_t)(k0 + wk) * g.ldw + tile_n + wn); if (DUAL) w42 = *(const float4*)(Wp2 + (size_t)(k0 + wk) * g.ldw + tile_n + wn); }
        __syncthreads();
#pragma unroll
        for (int i = 0; i < 4; ++i) As[ak + i][ar] = a4[i];
        Ws[0][wk][wn + 0] = w4.x; Ws[0][wk][wn + 1] = w4.y; Ws[0][wk][wn + 2] = w4.z; Ws[0][wk][wn + 3] = w4.w;
        if (DUAL) { Ws[1][wk][wn + 0] = w42.x; Ws[1][wk][wn + 1] = w42.y; Ws[1][wk][wn + 2] = w42.z; Ws[1][wk][wn + 3] = w42.w; }
        __syncthreads();
#pragma unroll
        for (int kk = 0; kk < 16; ++kk) {
            float a[4], w[4], w2[4];
#pragma unroll
            for (int i = 0; i < 4; ++i) a[i] = As[kk][ty * 4 + i];
#pragma unroll
            for (int j = 0; j < 4; ++j) { w[j] = Ws[0][kk][tx * 4 + j]; w2[j] = DUAL ? Ws[1][kk][tx * 4 + j] : 0.f; }
#pragma unroll
            for (int i = 0; i < 4; ++i)
#pragma unroll
                for (int j = 0; j < 4; ++j) { acc[i][j] += a[i] * w[j]; if (DUAL) acc2[i][j] += a[i] * w2[j]; }
        }
    }
#pragma unroll
    for (int i = 0; i < 4; ++i)
#pragma unroll
        for (int j = 0; j < 4; ++j) { const int m = tile_m + ty * 4 + i, n = tile_n + tx * 4 + j; if (m < M && n < g.N) g.store(z, m, n, acc[i][j], acc2[i][j]); }
}
template <class G, bool DUAL>
__device__ __forceinline__ void gemm_phase_naive(const G& g, int mt, int nt, int nz, int tid512, float* lds) {
    const int half = tid512 >> 8, tid = tid512 & 255; float* ldsh = lds + half * (3 * 16 * 68);
    const int nvb = mt * nt * nz, stride = 2 * (int)gridDim.x;
    for (int v0 = 2 * (int)blockIdx.x; v0 < nvb; v0 += stride) {
        const int vb = v0 + half; const bool active = vb < nvb; const int vv = active ? vb : 0;
        const int x = vv % mt, y = (vv / mt) % nt, z = vv / (mt * nt);
        gemm_tile_naive<G, DUAL>(g, z, x * 64, y * 64, active, tid, ldsh);
    }
}
template <class G, bool DUAL>
__device__ __forceinline__ void gemm_phase_moe_naive(const G& g, const int* cnt, int nt, int tid512, float* lds) {
    const int half = tid512 >> 8, tid = tid512 & 255; float* ldsh = lds + half * (3 * 16 * 68);
    int pre[17]; pre[0] = 0;
#pragma unroll
    for (int e = 0; e < 16; ++e) pre[e + 1] = pre[e] + (cnt[e] + 63) / 64;
    const int nvb = pre[16] * nt, stride = 2 * (int)gridDim.x;
    for (int v0 = 2 * (int)blockIdx.x; v0 < nvb; v0 += stride) {
        const int vb = v0 + half; const bool active = vb < nvb; const int vv = active ? vb : 0;
        const int mtile = vv / nt, y = vv % nt; int e = 0;
#pragma unroll
        for (int q = 1; q < 16; ++q) e += (mtile >= pre[q]) ? 1 : 0;
        int pe = 0;
#pragma unroll
        for (int q = 0; q < 16; ++q) pe = (q == e) ? pre[q] : pe;
        gemm_tile_naive<G, DUAL>(g, e, (mtile - pe) * 64, y * 64, active, tid, ldsh);
    }
}

struct GProj0 {
    const bf16* xn; const float* w; bf16 *qkraw, *vmt, *om, *qb, *kb, *vbt; const float* abias; int N, K, ldw;
    __device__ int M(int) const { return T_; }
    __device__ const bf16* arow(int, int m) const { return xn + (size_t)m * D_; }
    __device__ const float* W(int) const { return w; }
    __device__ const float* W2(int) const { return w; }
    __device__ void store(int, int m, int n, float v, float) const {
        const int b = m >> 11, s = m & 2047; const bf16 o = f2bf(v);
        if (n < 1024) qkraw[(size_t)m * 1024 + n] = o;
        else if (n < 1536) { const int c = n - 1024; vmt[((size_t)(b * 4 + (c >> 7)) * 128 + (c & 127)) * 2048 + s] = o; }
        else if (n < 2048) om[(size_t)m * 512 + (n - 1536)] = o;
        else if (n < 2056) {}
        else if (n < 2568) { const int c = n - 2056; qb[((size_t)(b * 4 + (c >> 7)) * 2048 + s) * 128 + (c & 127)] = o; }
        else if (n < 3080) { const int c = n - 2568; kb[((size_t)(b * 4 + (c >> 7)) * 2048 + s) * 128 + (c & 127)] = o; }
        else { const int c = n - 3080; vbt[((size_t)(b * 4 + (c >> 7)) * 128 + (c & 127)) * 2048 + s] = o; }
    }
};
struct GProj1 {
    const bf16* xn; const float* w; bf16 *q1, *kc, *vc, *ks, *vst, *kw, *vwt; const float* abias; int N, K, ldw;
    __device__ int M(int) const { return T_; }
    __device__ const bf16* arow(int, int m) const { return xn + (size_t)m * D_; }
    __device__ const float* W(int) const { return w; }
    __device__ const float* W2(int) const { return w; }
    __device__ void store(int, int m, int n, float v, float) const {
        const int b = m >> 11, s = m & 2047; const bf16 o = f2bf(v);
        if (n < 1024) q1[((size_t)(b * 8 + (n >> 7)) * 2048 + s) * 128 + (n & 127)] = o;
        else if (n < 2560) { const int c = n - 1024, which = c >> 8, cc = c & 255, gI = cc >> 7, d = cc & 127;
            const size_t hm = ((size_t)(b * 2 + gI) * 2048 + s) * 128 + d, tm = ((size_t)(b * 2 + gI) * 128 + d) * 2048 + s;
            if (which == 0) kc[hm] = o; else if (which == 1) vc[hm] = o; else if (which == 2) ks[hm] = o; else if (which == 3) vst[tm] = o; else if (which == 4) kw[hm] = o; else vwt[tm] = o; }
    }
};
struct GOut {
    const bf16* y; const float* w; const float* hin; float* hout; const float* abias; int N, K, ldw;
    __device__ int M(int) const { return T_; }
    __device__ const bf16* arow(int, int m) const { return y + (size_t)m * D_; }
    __device__ const float* W(int) const { return w; }
    __device__ const float* W2(int) const { return w; }
    __device__ void store(int, int m, int n, float v, float) const { const size_t i = (size_t)m * D_ + n; hout[i] = hin[i] + v; }
};
__device__ __forceinline__ int moe_row_base(const int* cnt, int z) { int acc = 0;
#pragma unroll
    for (int e = 0; e < 16; ++e) acc += (e < z) ? ((cnt[e] + 255) & ~255) : 0;
    return acc; }
struct GMoe1 {
    const bf16* xn; const float* w1; const float* w3; const int* cnt; const int* list; bf16* H; const float* abias; int N, K, ldw;
    __device__ int M(int z) const { return cnt[z]; }
    __device__ const bf16* arow(int z, int m) const { return xn + (size_t)(list[z * T_ + m] >> 1) * D_; }
    __device__ const float* W(int z) const { return w1 + (size_t)z * 1024 * 256; }
    __device__ const float* W2(int z) const { return w3 + (size_t)z * 1024 * 256; }
    __device__ void store(int z, int m, int n, float a, float b) const { H[(size_t)(moe_row_base(cnt, z) + m) * 256 + n] = f2bf(a * sigmoidf_(a) * b); }
};
struct GMoe2 {
    const bf16* H; const float* w2; const int* cnt; const int* list; const float* listw; bf16* ys0; bf16* ys1; const float* abias; int N, K, ldw;
    __device__ int M(int z) const { return cnt[z]; }
    __device__ const bf16* arow(int z, int m) const { return H + (size_t)(moe_row_base(cnt, z) + m) * 256; }
    __device__ const float* W(int z) const { return w2 + (size_t)z * 256 * 1024; }
    __device__ const float* W2(int z) const { return w2; }
    __device__ void store(int z, int m, int n, float v, float) const { const int e = list[z * T_ + m]; const float w = listw[z * T_ + m];
        bf16* ys = (e & 1) ? ys1 : ys0; ys[(size_t)(e >> 1) * D_ + n] = f2bf(w * v); }
};
struct GCmp1 {
    const bf16* kc; const bf16* vc; const float* wk1; const float* wv1; const float* pe; bf16* hc; const float* abias; int N, K, ldw;
    __device__ int M(int) const { return 2048; }
    __device__ const bf16* arow(int z, int r) const { const int bg = r >> 7, nb = r & 127; if (nb == 127) return nullptr; return (z ? vc : kc) + ((size_t)bg * 2048 + 16 * nb) * 128; }
    __device__ const float* W(int z) const { return z ? wv1 : wk1; }
    __device__ const float* W2(int z) const { return wk1; }
    __device__ void store(int z, int r, int n, float v, float) const { const float u = 0.7978845608028654f * (v + 0.044715f * v * v * v); hc[((size_t)z * 2048 + r) * 256 + n] = f2bf(0.5f * v * (1.f + tanhf(u))); }
};
struct GCmp2 {
    const float* part; const float* cb; const float* wk2; const float* wv2; bf16* kcmp; bf16* vcmpt; int N, K, ldw;
    __device__ int M(int) const { return 2048; }
    __device__ void aload(int z, int r, int k, float (&a4)[4]) const {
        float4 sacc = *(const float4*)(cb + z * 256 + k);
#pragma unroll
        for (int ks = 0; ks < 4; ++ks) { const float4 p = *(const float4*)(part + ((size_t)(ks * 2 + z) * 2048 + r) * 256 + k); sacc.x += p.x; sacc.y += p.y; sacc.z += p.z; sacc.w += p.w; }
        const float v[4] = {sacc.x, sacc.y, sacc.z, sacc.w};
#pragma unroll
        for (int i = 0; i < 4; ++i) { const float u = 0.7978845608028654f * (v[i] + 0.044715f * v[i] * v[i] * v[i]); a4[i] = bf2f(f2bf(0.5f * v[i] * (1.f + tanhf(u)))); }
    }
    __device__ const float* W(int z) const { return z ? wv2 : wk2; }
    __device__ const float* W2(int z) const { return wk2; }
    __device__ void store(int z, int r, int n, float v, float) const { const int bg = r >> 7, nb = r & 127; const float vv = (nb == 127) ? 0.f : v;
        if (z == 0) kcmp[((size_t)bg * 128 + nb) * 128 + n] = f2bf(vv); else vcmpt[((size_t)bg * 128 + n) * 128 + nb] = f2bf(vv); }
};

template <int NAUX, int NP>
__device__ __forceinline__ void stage_aux(LAS float* Wl, const float* W0, int ld0, int n0, const float* W1, int ld1, int tid) {
    typedef float f4v __attribute__((ext_vector_type(4)));
    f4v buf[2][NAUX / 4];
#pragma unroll
    for (int kk = 0; kk < 2; ++kk) { const int k = tid + 512 * kk;
#pragma unroll
        for (int c4 = 0; c4 < NAUX / 4; ++c4) buf[kk][c4] = (4 * c4 < n0) ? *(const f4v*)(W0 + (size_t)k * ld0 + 4 * c4) : *(const f4v*)(W1 + (size_t)k * ld1 + (4 * c4 - n0)); }
#pragma unroll
    for (int kk = 0; kk < 2; ++kk) { const int k = tid + 512 * kk; const int slot = (((k >> 8) * 4 + (k & 3)) * 64 + ((k & 255) >> 2));
#pragma unroll
        for (int c4 = 0; c4 < NAUX / 4; ++c4) *(LAS f4v*)(Wl + slot * NP + 4 * c4) = buf[kk][c4]; }
}
template <int NAUX, int NP, class Emit>
__device__ __forceinline__ void aux_dots(const float (&v)[16], const LAS float* Wl, int lane, const Emit& emit, int c4a = 0, int c4b = NAUX / 4) {
    typedef float f4v __attribute__((ext_vector_type(4)));
#pragma nounroll
    for (int c4 = c4a; c4 < c4b; ++c4) {
        f4v a = {0.f, 0.f, 0.f, 0.f};
        const LAS float* wr = Wl + lane * NP + 4 * c4;
#pragma unroll
        for (int ji = 0; ji < 16; ++ji) { const f4v w = *(const LAS f4v*)(wr + ji * 64 * NP); a += v[ji] * w; }
        const float k0 = pair32(a[0], a[2]), k1 = pair32(a[1], a[3]);
        const float r = row16_sum(pair16(k0, k1));
        emit(4 * c4 + 2 * (lane >> 5) + ((lane >> 4) & 1), r);
    }
}
template <int NAUX, int NP, class Emit>
__device__ __forceinline__ void aux_dots2(const float (&va)[16], const float (&vb)[16], const LAS float* Wl, int lane, const Emit& emit, int c4a = 0, int c4b = NAUX / 4) {
    typedef float f4v __attribute__((ext_vector_type(4)));
#pragma nounroll
    for (int c4 = c4a; c4 < c4b; ++c4) {
        f4v a = {0.f, 0.f, 0.f, 0.f}, b = {0.f, 0.f, 0.f, 0.f};
        const LAS float* wr = Wl + lane * NP + 4 * c4;
#pragma unroll
        for (int ji = 0; ji < 16; ++ji) { const f4v w = *(const LAS f4v*)(wr + ji * 64 * NP); a += va[ji] * w; b += vb[ji] * w; }
        const float k0 = pair32(a[0], a[2]), k1 = pair32(a[1], a[3]), j0 = pair32(b[0], b[2]), j1 = pair32(b[1], b[3]);
        const float r = row16_sum(pair16(k0, k1)), q = row16_sum(pair16(j0, j1));
        const int col = 4 * c4 + 2 * (lane >> 5) + ((lane >> 4) & 1);
        emit(0, col, r); emit(1, col, q);
    }
}
struct RowNormArgs { const float* base; const bf16* baseh; const bf16* add0; const bf16* add1; bf16* hout; const float* gain; bf16* xn; float* fout; int auxAct; float* auxOut; float4 g[4]; };
struct RowRaw { float4 b[4]; uint2 a0[4]; uint2 a1[4]; };
template <class TB>
__device__ __forceinline__ void row_load(RowRaw& rr, const TB* base, const bf16* add0, const bf16* add1, int row, int lane) {
    const size_t ro = (size_t)row * D_;
    typedef float f4v __attribute__((ext_vector_type(4))); typedef unsigned u2v __attribute__((ext_vector_type(2)));
#pragma unroll
    for (int j = 0; j < 4; ++j) {
        if (sizeof(TB) == 4) { const f4v t = __builtin_nontemporal_load((const f4v*)((const float*)base + ro + j * 256 + lane * 4)); rr.b[j] = make_float4(t[0], t[1], t[2], t[3]); }
        else { const u2v t = __builtin_nontemporal_load((const u2v*)((const bf16*)base + ro + j * 256 + lane * 4)); rr.b[j] = make_float4(lo16(t[0]), hi16(t[0]), lo16(t[1]), hi16(t[1])); } }
    if (add0) {
#pragma unroll
        for (int j = 0; j < 4; ++j) { const u2v t0 = __builtin_nontemporal_load((const u2v*)(add0 + ro + j * 256 + lane * 4)); u2v t1 = {0u, 0u}; if (add1) t1 = __builtin_nontemporal_load((const u2v*)(add1 + ro + j * 256 + lane * 4));
            rr.a0[j] = make_uint2(t0[0], t0[1]); rr.a1[j] = make_uint2(t1[0], t1[1]); } }
}
__device__ __forceinline__ void rownorm_prep(const RowNormArgs& a, int row, int lane, const RowRaw& rr, float (&v)[16]) {
    const size_t ro = (size_t)row * D_;
#pragma unroll
    for (int j = 0; j < 4; ++j) { const float4 x = rr.b[j]; v[4 * j] = x.x; v[4 * j + 1] = x.y; v[4 * j + 2] = x.z; v[4 * j + 3] = x.w; }
    if (a.add0) {
#pragma unroll
        for (int j = 0; j < 4; ++j) { const uint2 u = rr.a0[j], w = rr.a1[j];
            v[4 * j] += lo16(u.x) + lo16(w.x); v[4 * j + 1] += hi16(u.x) + hi16(w.x); v[4 * j + 2] += lo16(u.y) + lo16(w.y); v[4 * j + 3] += hi16(u.y) + hi16(w.y); } }
    if (a.hout) {
#pragma unroll
        for (int j = 0; j < 4; ++j) { uint2 o; o.x = pk2(v[4 * j], v[4 * j + 1]); o.y = pk2(v[4 * j + 2], v[4 * j + 3]); *(uint2*)(a.hout + ro + j * 256 + lane * 4) = o; } }
    float ss = 0.f;
#pragma unroll
    for (int i = 0; i < 16; ++i) ss += v[i] * v[i];
    ss = wave_sum(ss);
    const float rstd = rsqrtf(ss * (1.f / D_) + 1e-6f);
#pragma unroll
    for (int j = 0; j < 4; ++j) { const float4 gg = a.g[j]; v[4 * j] *= rstd * gg.x; v[4 * j + 1] *= rstd * gg.y; v[4 * j + 2] *= rstd * gg.z; v[4 * j + 3] *= rstd * gg.w; }
    if (a.xn) {
#pragma unroll
        for (int j = 0; j < 4; ++j) { uint2 o; o.x = (unsigned)f2bf(v[4 * j]) | ((unsigned)f2bf(v[4 * j + 1]) << 16); o.y = (unsigned)f2bf(v[4 * j + 2]) | ((unsigned)f2bf(v[4 * j + 3]) << 16);
            *(uint2*)(a.xn + ro + j * 256 + lane * 4) = o; } }
    if (a.fout) { typedef float f4v __attribute__((ext_vector_type(4)));
#pragma unroll
        for (int j = 0; j < 4; ++j) { const f4v t = {v[4 * j], v[4 * j + 1], v[4 * j + 2], v[4 * j + 3]}; __builtin_nontemporal_store(t, (f4v*)(a.fout + ro + j * 256 + lane * 4)); } }
}
template <int NAUX, int NP>
__device__ __forceinline__ void rownorm_row(const RowNormArgs& a, int row, int lane, const LAS float* Wl, const RowRaw& rr) {
    float v[16]; rownorm_prep(a, row, lane, rr, v);
    if (NAUX > 0) {
        float* out = a.auxOut + (size_t)row * NAUX; const int act = a.auxAct;
        aux_dots<(NAUX > 0 ? NAUX : 4), NP>(v, Wl, lane, [=](int col, float r) { if ((lane & 15) == 0) out[col] = act ? sigmoidf_(r) : r; });
    }
}
template <int NAUX, int NP>
__device__ __forceinline__ void rownorm_row2(const RowNormArgs& a, int row0, int row1, int lane, const LAS float* Wl, const RowRaw& ra, const RowRaw& rb) {
    float va[16], vb[16]; rownorm_prep(a, row0, lane, ra, va); rownorm_prep(a, row1, lane, rb, vb);
    if (NAUX > 0) {
        float* out0 = a.auxOut + (size_t)row0 * NAUX; float* out1 = a.auxOut + (size_t)row1 * NAUX; const int act = a.auxAct;
        aux_dots2<(NAUX > 0 ? NAUX : 4), NP>(va, vb, Wl, lane, [=](int which, int col, float r) { if ((lane & 15) == 0) (which ? out1 : out0)[col] = act ? sigmoidf_(r) : r; });
    }
}

struct RouteArgs { const bf16* h; const float* gain; const float* bg; const float* be; int* cnt; int* list; float* listw; float4 g[4]; };
__device__ __forceinline__ float route_prep(const RouteArgs& a, int lane, const RowRaw& rr, float (&v)[16]) {
#pragma unroll
    for (int j = 0; j < 4; ++j) { const float4 x = rr.b[j]; v[4 * j] = x.x; v[4 * j + 1] = x.y; v[4 * j + 2] = x.z; v[4 * j + 3] = x.w; }
    float ss = 0.f;
#pragma unroll
    for (int i = 0; i < 16; ++i) ss += v[i] * v[i];
    ss = wave_sum(ss);
    const float rstd = rsqrtf(ss * (1.f / D_) + 1e-6f);
#pragma unroll
    for (int j = 0; j < 4; ++j) { const float4 gg = a.g[j]; v[4 * j] *= rstd * gg.x; v[4 * j + 1] *= rstd * gg.y; v[4 * j + 2] *= rstd * gg.z; v[4 * j + 3] *= rstd * gg.w; }
    return rstd;
}
__device__ __forceinline__ void route_finish(int row, float rstd, int lane, volatile float* L, volatile LAS int* rec, LAS int* lcnt, bool active_lane = true, bool use_active = false) {
    if (use_active ? active_lane : lane == 0) {
        float lg[4];
#pragma unroll
        for (int j = 0; j < 4; ++j) lg[j] = L[j];
        int gt = 0; float gm = lg[0];
#pragma unroll
        for (int j = 1; j < 4; ++j) if (lg[j] > gm) { gm = lg[j]; gt = j; }
        float den = 0.f;
#pragma unroll
        for (int j = 0; j < 4; ++j) den += __expf(lg[j] - gm);
        const float gw = __builtin_amdgcn_rcpf(den);
        float le[4];
#pragma unroll
        for (int j = 0; j < 4; ++j) le[j] = L[4 + gt * 4 + j];
        int i0 = 0; float v0 = le[0];
#pragma unroll
        for (int j = 1; j < 4; ++j) if (le[j] > v0) { v0 = le[j]; i0 = j; }
        int i1 = -1; float v1 = 0.f;
#pragma unroll
        for (int j = 0; j < 4; ++j) { if (j == i0) continue; const float x = le[j]; if (i1 < 0 || x > v1) { v1 = x; i1 = j; } }
        const float e = __expf(v1 - v0), w0 = gw * __builtin_amdgcn_rcpf(1.f + e), w1 = w0 * e;
        const int e0 = gt * 4 + i0, e1 = gt * 4 + i1;
        const int p0 = atomicAdd((int*)(lcnt + e0), 1), p1 = atomicAdd((int*)(lcnt + e1), 1);
        rec[0] = row; rec[1] = e0; rec[2] = e1; rec[3] = p0; rec[4] = p1; ((volatile LAS float*)rec)[5] = w0; ((volatile LAS float*)rec)[6] = w1; ((volatile LAS float*)rec)[7] = rstd;
    }
}
__device__ __forceinline__ void route_row(const RouteArgs& a, int row, int lane, volatile float* L, const LAS float* Wl, volatile LAS int* rec, LAS int* lcnt, const RowRaw& rr) {
    float v[16]; const float rstd = route_prep(a, lane, rr, v);
    {   const float* bg = a.bg; const float* be = a.be;
        aux_dots<20, 20>(v, Wl, lane, [=](int col, float r) { if ((lane & 15) == 0) L[col] = r + (col < 4 ? bg[col & 3] : be[(col - 4) & 15]); }); }
    route_finish(row, rstd, lane, L, rec, lcnt);
}
__device__ __forceinline__ void route_row2(const RouteArgs& a, int row0, int row1, int lane, volatile float* L, const LAS float* Wl, volatile LAS int* rec0, volatile LAS int* rec1, LAS int* lcnt, const RowRaw& ra, const RowRaw& rb) {
    float va[16], vb[16]; const float rs0 = route_prep(a, lane, ra, va), rs1 = route_prep(a, lane, rb, vb);
    {   const float* bg = a.bg; const float* be = a.be;
        aux_dots2<20, 20>(va, vb, Wl, lane, [=](int which, int col, float r) { if ((lane & 15) == 0) L[32 * which + col] = r + bg[col & 3]; }, 0, 1);
        int g0 = 0, g1 = 0; { float m0 = L[0], m1 = L[32];
#pragma unroll
            for (int j = 1; j < 4; ++j) { const float x0 = L[j], x1 = L[32 + j]; if (x0 > m0) { m0 = x0; g0 = j; } if (x1 > m1) { m1 = x1; g1 = j; } } }
        g0 = __builtin_amdgcn_readfirstlane(g0); g1 = __builtin_amdgcn_readfirstlane(g1);
        if (g0 == g1) aux_dots2<20, 20>(va, vb, Wl, lane, [=](int which, int col, float r) { if ((lane & 15) == 0) L[32 * which + col] = r + be[(col - 4) & 15]; }, 1 + g0, 2 + g0);
        else { aux_dots<20, 20>(va, Wl, lane, [=](int col, float r) { if ((lane & 15) == 0) L[col] = r + be[(col - 4) & 15]; }, 1 + g0, 2 + g0);
               aux_dots<20, 20>(vb, Wl, lane, [=](int col, float r) { if ((lane & 15) == 0) L[32 + col] = r + be[(col - 4) & 15]; }, 1 + g1, 2 + g1); } }
    route_finish(lane ? row1 : row0, lane ? rs1 : rs0, lane, L + 32 * (lane & 1), lane ? rec1 : rec0, lcnt, lane < 2, true);
}

__device__ __forceinline__ void conv_silu_elem(size_t idx, const bf16* qkraw, const float* cw, bf16* qm, bf16* km) {
    const int m = (int)(idx >> 10), c = (int)(idx & 1023), b = m >> 11, s = m & 2047;
    float acc = 0.f;
#pragma unroll
    for (int j = 0; j < 4; ++j) { const int ss = s - 3 + j; if (ss >= 0) acc += cw[j * 1024 + c] * bf2f(qkraw[(size_t)(m - 3 + j) * 1024 + c]); }
    const float y = acc * sigmoidf_(acc);
    const int cc = c & 511, hh = cc >> 7, d = cc & 127;
    (c < 512 ? qm : km)[((size_t)(b * 4 + hh) * 2048 + s) * 128 + d] = f2bf(y);
}
__device__ __forceinline__ void conv_silu_vec(size_t idx, const bf16* qkraw, const float* cw, bf16* qm, bf16* km) {
    const int m = (int)(idx >> 7), c0 = (int)(idx & 127) * 8, b = m >> 11, s = m & 2047;
    float acc[8];
#pragma unroll
    for (int e = 0; e < 8; ++e) acc[e] = 0.f;
#pragma unroll
    for (int j = 0; j < 4; ++j) { if (s - 3 + j >= 0) { const uint4 u = *(const uint4*)(qkraw + (size_t)(m - 3 + j) * 1024 + c0); const float4 w0 = *(const float4*)(cw + j * 1024 + c0), w1 = *(const float4*)(cw + j * 1024 + c0 + 4);
            acc[0] += w0.x * lo16(u.x); acc[1] += w0.y * hi16(u.x); acc[2] += w0.z * lo16(u.y); acc[3] += w0.w * hi16(u.y); acc[4] += w1.x * lo16(u.z); acc[5] += w1.y * hi16(u.z); acc[6] += w1.z * lo16(u.w); acc[7] += w1.w * hi16(u.w); } }
#pragma unroll
    for (int e = 0; e < 8; ++e) acc[e] = acc[e] * sigmoidf_(acc[e]);
    const int cc = c0 & 511, hh = cc >> 7, d = cc & 127;
    uint4 o; o.x = pk2(acc[0], acc[1]); o.y = pk2(acc[2], acc[3]); o.z = pk2(acc[4], acc[5]); o.w = pk2(acc[6], acc[7]);
    *(uint4*)((c0 < 512 ? qm : km) + ((size_t)(b * 4 + hh) * 2048 + s) * 128 + d) = o;
}
__device__ __forceinline__ void conv_silu_run(int item, const bf16* qkraw, const float* cw, bf16* qm, bf16* km) {
    const int cg = item & 127, c0 = cg * 8, m0 = (item >> 7) * 16, b = m0 >> 11, s0 = m0 & 2047;
    float w[4][8];
#pragma unroll
    for (int j = 0; j < 4; ++j) { const float4 w0 = *(const float4*)(cw + j * 1024 + c0), w1 = *(const float4*)(cw + j * 1024 + c0 + 4);
        w[j][0] = w0.x; w[j][1] = w0.y; w[j][2] = w0.z; w[j][3] = w0.w; w[j][4] = w1.x; w[j][5] = w1.y; w[j][6] = w1.z; w[j][7] = w1.w; }
    uint4 r0, r1, r2;
    const uint4 z4 = make_uint4(0u, 0u, 0u, 0u);
    r0 = s0 >= 3 ? *(const uint4*)(qkraw + (size_t)(m0 - 3) * 1024 + c0) : z4;
    r1 = s0 >= 2 ? *(const uint4*)(qkraw + (size_t)(m0 - 2) * 1024 + c0) : z4;
    r2 = s0 >= 1 ? *(const uint4*)(qkraw + (size_t)(m0 - 1) * 1024 + c0) : z4;
    const int cc = c0 & 511, hh = cc >> 7, d = cc & 127;
    bf16* dst = (c0 < 512 ? qm : km) + ((size_t)(b * 4 + hh) * 2048 + s0) * 128 + d;
    uint4 rr[16];
#pragma unroll
    for (int t = 0; t < 16; ++t) rr[t] = *(const uint4*)(qkraw + (size_t)(m0 + t) * 1024 + c0);
    float f[19][8];
#define CV_UNP(F, R) F[0] = lo16(R.x); F[1] = hi16(R.x); F[2] = lo16(R.y); F[3] = hi16(R.y); F[4] = lo16(R.z); F[5] = hi16(R.z); F[6] = lo16(R.w); F[7] = hi16(R.w);
    CV_UNP(f[0], r0) CV_UNP(f[1], r1) CV_UNP(f[2], r2)
#pragma unroll
    for (int t = 0; t < 16; ++t) { CV_UNP(f[t + 3], rr[t])
        float acc[8];
#pragma unroll
        for (int e = 0; e < 8; ++e) acc[e] = w[0][e] * f[t][e] + w[1][e] * f[t + 1][e] + w[2][e] * f[t + 2][e] + w[3][e] * f[t + 3][e];
#pragma unroll
        for (int e = 0; e < 8; ++e) acc[e] = acc[e] * sigmoidf_(acc[e]);
        uint4 o; o.x = pk2(acc[0], acc[1]); o.y = pk2(acc[2], acc[3]); o.z = pk2(acc[4], acc[5]); o.w = pk2(acc[6], acc[7]);
        *(uint4*)(dst + (size_t)t * 128) = o; }
#undef CV_UNP
}
__device__ __forceinline__ void gates_block(int bh, int tid, const float* ifr, const float* gb, float* li, float* bc, LAS float* xs  ) {
    const int b = bh >> 2, h = bh & 3, lane = tid & 63, w = tid >> 6; const float gbi = gb[h], gbf = gb[4 + h];
    float pi[4], lf[4], tot = 0.f;
#pragma unroll
    for (int i = 0; i < 4; ++i) { const size_t m = (size_t)b * 2048 + tid * 4 + i;
        const float xi = (ifr[m * 8 + h] + gbi) * (2.f / 15.f), xf = (ifr[m * 8 + 4 + h] + gbf) * (2.f / 15.f);
        pi[i] = 15.f - 30.f * __builtin_amdgcn_rcpf(1.f + __expf(xi)); const float pf = 15.f - 30.f * __builtin_amdgcn_rcpf(1.f + __expf(xf));
        lf[i] = -__logf(1.f + __expf(-pf)); tot += lf[i]; }
    float inc = tot;
#pragma unroll
    for (int o = 1; o < 64; o <<= 1) { const float t = __shfl_up(inc, o); if (lane >= o) inc += t; }
    if (lane == 63) xs[w] = inc;
    __syncthreads();
    float carry = 0.f;
#pragma unroll
    for (int q = 0; q < 8; ++q) carry += (q < w) ? xs[q] : 0.f;
    float run = carry + inc - tot;
#pragma unroll
    for (int i = 0; i < 4; ++i) { run += lf[i]; bc[bh * 2048 + tid * 4 + i] = run; li[bh * 2048 + tid * 4 + i] = pi[i]; }
    __syncthreads();
}
__device__ __forceinline__ void gates_wave(int bh, int lane, const float* ifr, const float* gb, float* li, float* bc) {
    const int b = bh >> 2, h = bh & 3; const float gbi = gb[h], gbf = gb[4 + h];
    float lf[32]; float tot = 0.f;
#pragma unroll
    for (int i = 0; i < 32; ++i) { const size_t m = (size_t)b * 2048 + lane * 32 + i;
        const float pi = 15.f * tanhf((ifr[m * 8 + h] + gbi) * (1.f / 15.f)), pf = 15.f * tanhf((ifr[m * 8 + 4 + h] + gbf) * (1.f / 15.f));
        li[bh * 2048 + lane * 32 + i] = pi; lf[i] = -log1pf(__expf(-pf)); tot += lf[i]; }
    float inc = tot;
#pragma unroll
    for (int o = 1; o < 64; o <<= 1) { const float t = __shfl_up(inc, o); if (lane >= o) inc += t; }
    float run = inc - tot;
#pragma unroll
    for (int i = 0; i < 32; ++i) { run += lf[i]; bc[bh * 2048 + lane * 32 + i] = run; }
}
__device__ __forceinline__ void rotary_elem(size_t idx, const bf16* src, bf16* dst, const float2* rot) {
    const size_t r = idx >> 6; const int i = (int)(idx & 63);
    const float2 cs = rot[(r & 2047) * 64 + i];
    const float x1 = bf2f(src[r * 128 + i]), x2 = bf2f(src[r * 128 + 64 + i]);
    dst[r * 128 + i] = f2bf(x1 * cs.x - x2 * cs.y); dst[r * 128 + 64 + i] = f2bf(x2 * cs.x + x1 * cs.y);
}

__device__ __forceinline__ float dot_qk(const volatile float* qs, const bf16* krow) {
    float acc = 0.f;
#pragma unroll
    for (int i = 0; i < 16; ++i) { const uint4 u = ((const uint4*)krow)[i];
        acc += qs[8 * i] * lo16(u.x) + qs[8 * i + 1] * hi16(u.x) + qs[8 * i + 2] * lo16(u.y) + qs[8 * i + 3] * hi16(u.y) + qs[8 * i + 4] * lo16(u.z) + qs[8 * i + 5] * hi16(u.z) + qs[8 * i + 6] * lo16(u.w) + qs[8 * i + 7] * hi16(u.w); }
    return acc;
}
__device__ __forceinline__ void pv_accum(float& a0, float& a1, float p, const bf16* v0, const bf16* v1, volatile float* pl, int lane) {
    pl[lane] = p;
#pragma unroll
    for (int i = 0; i < 8; ++i) { const uint4 u = ((const uint4*)v0)[i], w = ((const uint4*)v1)[i];
        const float p0 = pl[8 * i], p1 = pl[8 * i + 1], p2 = pl[8 * i + 2], p3 = pl[8 * i + 3], p4 = pl[8 * i + 4], p5 = pl[8 * i + 5], p6 = pl[8 * i + 6], p7 = pl[8 * i + 7];
        a0 += p0 * lo16(u.x) + p1 * hi16(u.x) + p2 * lo16(u.y) + p3 * hi16(u.y) + p4 * lo16(u.z) + p5 * hi16(u.z) + p6 * lo16(u.w) + p7 * hi16(u.w);
        a1 += p0 * lo16(w.x) + p1 * hi16(w.x) + p2 * lo16(w.y) + p3 * hi16(w.y) + p4 * lo16(w.z) + p5 * hi16(w.z) + p6 * lo16(w.w) + p7 * hi16(w.w); }
}
__device__ __forceinline__ void osm_step(float sc, bool valid, float& mrun, float& lrun, float& a0, float& a1, const bf16* v0, const bf16* v1, volatile float* pl, int lane) {
    const float cm = wave_max(valid ? sc : -3e38f);
    if (cm < -1e38f) return;
    const float mn = fmaxf(mrun, cm), alpha = __expf(mrun - mn);
    const float p = valid ? __expf(sc - mn) : 0.f;
    lrun = lrun * alpha + wave_sum(p); a0 *= alpha; a1 *= alpha; mrun = mn;
    pv_accum(a0, a1, p, v0, v1, pl, lane);
}
__device__ __forceinline__ void mlstm_query(int gid, int lane, volatile float* qs, const bf16* QM, const bf16* KM, const bf16* VMT, const float* LI, const float* BC, const bf16* OM, const float* gain, bf16* Y0) {
    const int t = gid & 2047, bh = gid >> 11;
    const bf16* qrow = QM + ((size_t)bh * 2048 + t) * 128;
    const float scale = 0.08838834764831845f;
    qs[2 * lane] = bf2f(qrow[2 * lane]) * scale; qs[2 * lane + 1] = bf2f(qrow[2 * lane + 1]) * scale;
    const float bt = BC[bh * 2048 + t];
    float n0 = 0.f, n1 = 0.f, den = 0.f;
    const bf16* v0 = VMT + ((size_t)bh * 128 + 2 * lane) * 2048; const bf16* v1 = v0 + 2048;
    for (int c = 0; c <= (t >> 6); ++c) {
        const int s = c * 64 + lane; float p = 0.f;
        if (s <= t) { const float d = dot_qk(qs, KM + ((size_t)bh * 2048 + s) * 128); p = d * __expf(bt - BC[bh * 2048 + s] + LI[bh * 2048 + s]); }
        den += p;
        pv_accum(n0, n1, p, v0 + c * 64, v1 + c * 64, qs + 128, lane);
    }
    den = wave_sum(den);
    const float dn = fmaxf(fabsf(den), 1.f), h0 = n0 / dn, h1 = n1 / dn;
    const float ms = wave_sum(h0 * h0 + h1 * h1) * (1.f / 128.f), r = rsqrtf(ms + 1e-6f);
    const int b = bh >> 2, h = bh & 3, col = h * 128 + 2 * lane; const size_t m = (size_t)b * 2048 + t;
    const float y0 = h0 * r * gain[col] * sigmoidf_(bf2f(OM[m * 512 + col])), y1 = h1 * r * gain[col + 1] * sigmoidf_(bf2f(OM[m * 512 + col + 1]));
    *(unsigned*)(Y0 + m * 1024 + col) = (unsigned)f2bf(y0) | ((unsigned)f2bf(y1) << 16);
}
__device__ __forceinline__ void moba_query(int gid, int lane, volatile float* qs, const bf16* QB, const bf16* KB, const bf16* VBT, bf16* Y0) {
    const int t = gid & 2047, bh = gid >> 11;
    const bf16* qrow = QB + ((size_t)bh * 2048 + t) * 128;
    qs[2 * lane] = bf2f(qrow[2 * lane]); qs[2 * lane + 1] = bf2f(qrow[2 * lane + 1]);
    const int cur = t >> 8;
    float gv = NEGINF;
    {
        for (int n = 0; n < cur; ++n) {
            float s0 = 0.f, s1 = 0.f; const bf16* kp = KB + ((size_t)bh * 2048 + n * 256) * 128 + 2 * lane;
            for (int j = 0; j < 256; ++j) { const unsigned u = *(const unsigned*)(kp + (size_t)j * 128); s0 += lo16(u); s1 += hi16(u); }
            const float part = wave_sum(qs[2 * lane] * (s0 * (1.f / 256.f)) + qs[2 * lane + 1] * (s1 * (1.f / 256.f)));
            if (lane == n) gv = part;
        }
    }
    unsigned selmask = 0u; float gcur = (lane < 8) ? gv : -3e38f;
    for (int r = 0; r < 3; ++r) {
        const float mx = wave_max(gcur);
        const unsigned long long bal = __ballot(gcur == mx);
        const int win = __ffsll((long long)bal) - 1;
        if (mx > 0.5f * NEGINF) selmask |= 1u << win;
        if (lane == win) gcur = -3e38f;
    }
    const float scale = 0.08838834764831845f;
    float mrun = -3e38f, lrun = 0.f, a0 = 0.f, a1 = 0.f;
    const bf16* v0 = VBT + ((size_t)bh * 128 + 2 * lane) * 2048; const bf16* v1 = v0 + 2048;
    for (int n = 0; n <= cur; ++n) {
        if (n != cur && !((selmask >> n) & 1u)) continue;
        for (int c = 0; c < 4; ++c) {
            const int s = n * 256 + c * 64 + lane;
            if (n * 256 + c * 64 > t) break;
            const bool valid = s <= t;
            float sc = 0.f; if (valid) sc = dot_qk(qs, KB + ((size_t)bh * 2048 + s) * 128) * scale;
            osm_step(sc, valid, mrun, lrun, a0, a1, v0 + n * 256 + c * 64, v1 + n * 256 + c * 64, qs + 128, lane);
        }
    }
    const float inv = 1.f / fmaxf(lrun, 1e-30f);
    const int b = bh >> 2, h = bh & 3, col = 512 + h * 128 + 2 * lane; const size_t m = (size_t)b * 2048 + t;
    *(unsigned*)(Y0 + m * 1024 + col) = (unsigned)f2bf(a0 * inv) | ((unsigned)f2bf(a1 * inv) << 16);
}
__device__ __forceinline__ void nsa_cmp_query(int gid, int lane, volatile float* Q, volatile float* P, const bf16* Q1, const bf16* KCMP, const bf16* VCMPT, bf16* OC, unsigned* SELM) {
    const int s = gid & 2047, bg = gid >> 11, b = bg >> 1, g = bg & 1;
    const float scale = 0.08838834764831845f;
    float imp0 = 0.f, imp1 = 0.f;
    for (int r = 0; r < 4; ++r) {
        const bf16* qrow = Q1 + ((size_t)(b * 8 + g * 4 + r) * 2048 + s) * 128;
        Q[2 * lane] = bf2f(qrow[2 * lane]); Q[2 * lane + 1] = bf2f(qrow[2 * lane + 1]);
        const int n0 = lane, n1 = lane + 64;
        const bool ok0 = (16 * n0 + 31) <= s, ok1 = (n1 < 127) && ((16 * n1 + 31) <= s);
        float s0 = 0.f, s1 = 0.f;
        if (ok0) s0 = dot_qk(Q, KCMP + ((size_t)bg * 128 + n0) * 128) * scale;
        if (ok1) s1 = dot_qk(Q, KCMP + ((size_t)bg * 128 + n1) * 128) * scale;
        const float mx = wave_max(fmaxf(ok0 ? s0 : -3e38f, ok1 ? s1 : -3e38f));
        const float p0 = ok0 ? __expf(s0 - mx) : 0.f, p1 = ok1 ? __expf(s1 - mx) : 0.f;
        const float sum = wave_sum(p0 + p1), inv = 1.f / fmaxf(sum, 1e-30f);
        const float q0 = p0 * inv, q1 = p1 * inv;
        imp0 += q0; imp1 += q1;
        P[n0] = q0; P[n1] = q1;
        float a0 = 0.f, a1 = 0.f;
        const bf16* v0 = VCMPT + ((size_t)bg * 128 + 2 * lane) * 128; const bf16* v1 = v0 + 128;
        for (int n = 0; n < 127; ++n) { const float p = P[n]; a0 += p * bf2f(v0[n]); a1 += p * bf2f(v1[n]); }
        const size_t m = (size_t)b * 2048 + s; const int col = (g * 4 + r) * 128 + 2 * lane;
        *(unsigned*)(OC + m * 1024 + col) = (unsigned)f2bf(a0) | ((unsigned)f2bf(a1) << 16);
    }
    P[lane] = imp0; P[lane + 64] = imp1;
    const int cur = s >> 6;
    float val = -3e38f;
    if (lane < 32) { const int j = lane; float im = 0.f;
        for (int n = 4 * j - 1; n <= 4 * j + 3; ++n) if (n >= 0 && n < 127) im += P[n];
        const bool forced = (j == 0) || (j == cur) || (j == cur - 1);
        val = (j <= cur) ? (forced ? 1e4f : im) : NEGINF; }
    unsigned mask = 0u;
    for (int r = 0; r < 8; ++r) {
        const float mx = wave_max(val);
        const unsigned long long bal = __ballot(val == mx);
        const int win = __ffsll((long long)bal) - 1;
        if (mx > 0.5f * NEGINF) mask |= 1u << win;
        if (lane == win) val = -3e38f;
    }
    if (lane == 0) SELM[bg * 2048 + s] = mask;
}
__device__ __forceinline__ void nsa_selwin_query(int gid, int lane, volatile float* qs, const bf16* Q1R, const bf16* KS, const bf16* VST, const bf16* KW, const bf16* VWT, const bf16* OC, const unsigned* SELM, const float* G, bf16* Y1) {
    const int s = gid & 2047, bh = gid >> 11, b = bh >> 3, hd = bh & 7, bg = b * 2 + (hd >> 2);
    const bf16* qrow = Q1R + ((size_t)bh * 2048 + s) * 128;
    qs[2 * lane] = bf2f(qrow[2 * lane]); qs[2 * lane + 1] = bf2f(qrow[2 * lane + 1]);
    const float scale = 0.08838834764831845f;
    const unsigned mask = SELM[bg * 2048 + s];
    const int cur = s >> 6;
    float os0, os1, ow0, ow1;
    {   float mrun = -3e38f, lrun = 0.f, a0 = 0.f, a1 = 0.f;
        const bf16* v0 = VST + ((size_t)bg * 128 + 2 * lane) * 2048; const bf16* v1 = v0 + 2048;
        for (int j = 0; j <= cur; ++j) { if (!((mask >> j) & 1u)) continue;
            const int k = j * 64 + lane; const bool valid = k <= s;
            float sc = 0.f; if (valid) sc = dot_qk(qs, KS + ((size_t)bg * 2048 + k) * 128) * scale;
            osm_step(sc, valid, mrun, lrun, a0, a1, v0 + j * 64, v1 + j * 64, qs + 128, lane); }
        const float inv = 1.f / fmaxf(lrun, 1e-30f); os0 = a0 * inv; os1 = a1 * inv; }
    {   float mrun = -3e38f, lrun = 0.f, a0 = 0.f, a1 = 0.f;
        const bf16* v0 = VWT + ((size_t)bg * 128 + 2 * lane) * 2048; const bf16* v1 = v0 + 2048;
        for (int j = (cur >= 8 ? cur - 8 : 0); j <= cur; ++j) {
            const int k = j * 64 + lane; const bool valid = (k <= s) && (s - k < 512);
            float sc = 0.f; if (valid) sc = dot_qk(qs, KW + ((size_t)bg * 2048 + k) * 128) * scale;
            osm_step(sc, valid, mrun, lrun, a0, a1, v0 + j * 64, v1 + j * 64, qs + 128, lane); }
        const float inv = 1.f / fmaxf(lrun, 1e-30f); ow0 = a0 * inv; ow1 = a1 * inv; }
    const size_t m = (size_t)b * 2048 + s; const int col = hd * 128 + 2 * lane;
    const float g0 = G[m * 24 + hd * 3], g1 = G[m * 24 + hd * 3 + 1], g2 = G[m * 24 + hd * 3 + 2];
    const unsigned oc = *(const unsigned*)(OC + m * 1024 + col);
    const float y0 = g0 * lo16(oc) + g1 * os0 + g2 * ow0, y1 = g0 * hi16(oc) + g1 * os1 + g2 * ow1;
    *(unsigned*)(Y1 + m * 1024 + col) = (unsigned)f2bf(y0) | ((unsigned)f2bf(y1) << 16);
}

constexpr size_t WB_W0T = 0;
constexpr size_t WB_WO0T = WB_W0T + (size_t)3584 * 1024;
constexpr size_t WB_W13T0 = WB_WO0T + (size_t)1024 * 1024;
constexpr size_t WB_W2T0 = WB_W13T0 + (size_t)16 * 512 * 1024;
constexpr size_t WB_W1T = WB_W2T0 + (size_t)16 * 1024 * 256;
constexpr size_t WB_WO1T = WB_W1T + (size_t)2560 * 1024;
constexpr size_t WB_W13T1 = WB_WO1T + (size_t)1024 * 1024;
constexpr size_t WB_W2T1 = WB_W13T1 + (size_t)16 * 512 * 1024;
constexpr size_t WB_CK1T = WB_W2T1 + (size_t)16 * 1024 * 256;
constexpr size_t WB_CV1T = WB_CK1T + (size_t)256 * 4096;
constexpr size_t WB_CK2T = WB_CV1T + (size_t)256 * 4096;
constexpr size_t WB_CV2T = WB_CK2T + (size_t)128 * 256;
constexpr size_t WB_END = WB_CV2T + (size_t)128 * 256;
static_assert(WS_WB + WB_END * 2 <= WS_R0, "bf16 weights fit");

typedef unsigned v4u __attribute__((ext_vector_type(4)));
__device__ __forceinline__ int rot_feat(int p) { return (p & ~127) + 4 * ((p & 127) >> 3) + (p & 3) + 64 * ((p >> 2) & 1); }
template <bool ROTP>
__device__ __forceinline__ void transpose_item(const float* W, int ldw, int col0, int K, bf16* WT, int row0, int kb, int nb, LAS float* scr, int lane) {
    const int k0 = 64 * kb, n0 = 32 * nb; const int nl = n0 + (lane & 31), sc = col0 + (ROTP ? rot_feat(nl) : nl);
#pragma unroll 8
    for (int i = 0; i < 32; ++i) { const int kk = 2 * i + (lane >> 5); scr[kk * 33 + (lane & 31)] = W[(size_t)(k0 + kk) * ldw + sc]; }
    asm volatile("s_waitcnt lgkmcnt(0)" ::: "memory");
    const int c = lane & 7;
#pragma unroll
    for (int j = 0; j < 4; ++j) { const int n = (lane >> 3) + 8 * j; const LAS float* s = scr + (8 * c) * 33 + n;
        v4u o; o.x = pk2(s[0 * 33], s[1 * 33]); o.y = pk2(s[2 * 33], s[3 * 33]); o.z = pk2(s[4 * 33], s[5 * 33]); o.w = pk2(s[6 * 33], s[7 * 33]);
        *(v4u*)(WT + (size_t)(row0 + n0 + n) * K + k0 + 8 * c) = o; }
    asm volatile("s_waitcnt lgkmcnt(0)" ::: "memory");
}
template <int MODE>
__device__ __forceinline__ void transpose_block(const float* W, int ldw, int col0, int K, bf16* WT, int row0, int kb, int ncols, LAS float* scr, int tid, const float* kscale = nullptr) {
    const int wave = tid >> 6, lane = tid & 63, k0 = 64 * kb;
    __syncthreads();
    if (4 * lane < ncols) {
        int pos = 4 * lane;
        if (MODE == 1) { const int f = pos & 127; pos = (pos & ~127) + (f < 64 ? 8 * (f >> 2) : 8 * ((f - 64) >> 2) + 4); }
        typedef float f4v __attribute__((ext_vector_type(4)));
        f4v v[8];
#pragma unroll
        for (int i = 0; i < 8; ++i) v[i] = __builtin_nontemporal_load((const f4v*)(W + (size_t)(k0 + wave * 8 + i) * ldw + col0 + 4 * lane));
#pragma unroll
        for (int i = 0; i < 8; ++i) { LAS float* d = scr + (wave * 8 + i) * 257 + pos; const float ks = kscale ? kscale[k0 + wave * 8 + i] : 1.f; d[0] = v[i][0] * ks; d[1] = v[i][1] * ks; d[2] = v[i][2] * ks; d[3] = v[i][3] * ks; }
    }
    __syncthreads();
    const int c = lane & 7;
#pragma unroll
    for (int j = 0; j < 4; ++j) { const int d = wave * 32 + 8 * j + (lane >> 3);
        if (d < ncols) { const LAS float* sp = scr + (8 * c) * 257 + d;
            v4u o; o.x = pk2(sp[0 * 257], sp[1 * 257]); o.y = pk2(sp[2 * 257], sp[3 * 257]); o.z = pk2(sp[4 * 257], sp[5 * 257]); o.w = pk2(sp[6 * 257], sp[7 * 257]);
            const int drow = row0 + (MODE == 2 ? ((d >> 7) * 256 + (d & 127)) : d);
            *(v4u*)(WT + (size_t)drow * K + k0 + 8 * c) = o; } }
}
#define BSEG(W, ldw, col0, K, ncols, WT, row0, MODE) { const int _nbk = ((ncols) + 255) / 256, _ni = ((K) / 64) * _nbk; if (r < _ni) { const int _nb = r % _nbk; \
    transpose_block<MODE>(W, ldw, (col0) + 256 * _nb, K, WT, (row0) + 256 * _nb, r / _nbk, (ncols) < 256 ? (ncols) : 256, scr, tid); continue; } r -= _ni; }
#define CONV_SEG(W, ldw, col0, K, ncols, WT, row0) { const int _ni = ((K) / 64) * ((ncols) / 32); if (r < _ni) { const int _nb = (ncols) / 32; transpose_item<false>(W, ldw, col0, K, WT, row0, r / _nb, r % _nb, scr, lane); continue; } r -= _ni; }
#define CONV_SEG_ROT(W, ldw, col0, K, ncols, WT, row0) { const int _ni = ((K) / 64) * ((ncols) / 32); if (r < _ni) { const int _nb = (ncols) / 32; transpose_item<true>(W, ldw, col0, K, WT, row0, r / _nb, r % _nb, scr, lane); continue; } r -= _ni; }

struct TBlk { const float* src; bf16* dst; const float* ks; int ldw, K, ncols, mode; };
typedef float tbf4 __attribute__((ext_vector_type(4)));
__device__ __forceinline__ TBlk tb_make(const float* W, int ldw, int col0, int K, bf16* WT, int row0, int kb, int ncols, int mode, const float* kscale = nullptr) {
    TBlk t; t.src = W + (size_t)(64 * kb) * ldw + col0; t.dst = WT + (size_t)row0 * K + 64 * kb; t.ks = kscale ? kscale + 64 * kb : nullptr; t.ldw = ldw; t.K = K; t.ncols = ncols; t.mode = mode; return t; }
__device__ __forceinline__ void tb_load(const TBlk& t, tbf4 (&v)[8], float (&ks)[8], int wave, int lane) {
    if (4 * lane < t.ncols) {
#pragma unroll
        for (int i = 0; i < 8; ++i) v[i] = __builtin_nontemporal_load((const tbf4*)(t.src + (size_t)(wave * 8 + i) * t.ldw + 4 * lane)); }
#pragma unroll
    for (int i = 0; i < 8; ++i) ks[i] = t.ks ? t.ks[wave * 8 + i] : 1.f;
}
__device__ __forceinline__ void tb_put(const TBlk& t, const tbf4 (&v)[8], const float (&ks)[8], LAS float* scr, int wave, int lane) {
    if (4 * lane < t.ncols) {
        int pos = 4 * lane;
        if (t.mode == 1) { const int f = pos & 127; pos = (pos & ~127) + (f < 64 ? 8 * (f >> 2) : 8 * ((f - 64) >> 2) + 4); }
#pragma unroll
        for (int i = 0; i < 8; ++i) { LAS float* d = scr + (wave * 8 + i) * 257 + pos; d[0] = v[i][0] * ks[i]; d[1] = v[i][1] * ks[i]; d[2] = v[i][2] * ks[i]; d[3] = v[i][3] * ks[i]; } }
}
__device__ __forceinline__ void tb_get(const TBlk& t, const LAS float* scr, int wave, int lane) {
    const int c = lane & 7;
#pragma unroll
    for (int j = 0; j < 4; ++j) { const int d = wave * 32 + 8 * j + (lane >> 3);
        if (d < t.ncols) { const LAS float* sp = scr + (8 * c) * 257 + d;
            v4u o; o.x = pk2(sp[0 * 257], sp[1 * 257]); o.y = pk2(sp[2 * 257], sp[3 * 257]); o.z = pk2(sp[4 * 257], sp[5 * 257]); o.w = pk2(sp[6 * 257], sp[7 * 257]);
            const int drow = t.mode == 2 ? ((d >> 7) * 256 + (d & 127)) : d;
            *(v4u*)(t.dst + (size_t)drow * t.K + 8 * c) = o; } }
}
#define TSEG(out, W, ldw, col0, K, ncols, WT, row0, MODE) { const int _nbk = ((ncols) + 255) / 256, _ni = ((K) / 64) * _nbk; if (r < _ni) { const int _nb = r % _nbk; \
    out = tb_make(W, ldw, (col0) + 256 * _nb, K, WT, (row0) + 256 * _nb, r / _nbk, (ncols) < 256 ? (ncols) : 256, MODE); break; } r -= _ni; }
#define TMOE13(out, L, q) { const int q_ = (q), which_ = q_ >> 8, e_ = (q_ >> 4) & 15, kb_ = q_ & 15; const float* src_ = ((L) == 0 ? (which_ ? in[13] : in[12]) : (which_ ? in[29] : in[28])) + (size_t)e_ * 1024 * 256; \
    out = tb_make(src_, 256, 0, 1024, WB + ((L) == 0 ? WB_W13T0 : WB_W13T1) + (size_t)e_ * 512 * 1024, which_ * 128, kb_, 256, 2, (L) == 0 ? in[7] : in[23]); }
#define TMOE2(out, L, q2) { const int q_ = (q2), e_ = q_ >> 4, kb_ = (q_ >> 2) & 3, nb_ = q_ & 3; const float* src_ = ((L) == 0 ? in[14] : in[30]) + (size_t)e_ * 256 * 1024; \
    out = tb_make(src_, 1024, 256 * nb_, 256, WB + ((L) == 0 ? WB_W2T0 : WB_W2T1) + (size_t)e_ * 1024 * 256, 256 * nb_, kb_, 256, 0); }
#define DEC_P0(i_, out) do { int r = (i_); \
    TSEG(out, in[2], 3592, 0, 1024, 1024, WB + WB_W0T, 0, 0) TSEG(out, in[2], 3592, 1536, 1024, 512, WB + WB_W0T, 1024, 0) TSEG(out, in[2], 3592, 2056, 1024, 512, WB + WB_W0T, 1536, 1) \
    TSEG(out, in[2], 3592, 2568, 1024, 512, WB + WB_W0T, 2048, 1) TSEG(out, in[2], 3592, 1024, 1024, 512, WB + WB_W0T, 2560, 0) TSEG(out, in[2], 3592, 3080, 1024, 512, WB + WB_W0T, 3072, 0) } while (0)
#define DEC_P1(i_, out) do { int r = (i_); TSEG(out, in[6], 1024, 0, 1024, 1024, WB + WB_WO0T, 0, 0) TMOE13(out, 0, r) } while (0)
#define DEC_W2T0(i_, out) do { TMOE2(out, 0, (i_)) } while (0)
#define DEC_P7(i_, out) do { int r = (i_); \
    TSEG(out, in[16], 2584, 0, 1024, 1536, WB + WB_W1T, 0, 0) TSEG(out, in[16], 2584, 1536, 1024, 256, WB + WB_W1T, 1536, 1) TSEG(out, in[16], 2584, 2048, 1024, 256, WB + WB_W1T, 1792, 1) \
    TSEG(out, in[16], 2584, 1792, 1024, 256, WB + WB_W1T, 2048, 0) TSEG(out, in[16], 2584, 2304, 1024, 256, WB + WB_W1T, 2304, 0) TSEG(out, in[22], 1024, 0, 1024, 1024, WB + WB_WO1T, 0, 0) \
    TSEG(out, in[18], 256, 0, 4096, 256, WB + WB_CK1T, 0, 0) TSEG(out, in[20], 256, 0, 4096, 256, WB + WB_CV1T, 0, 0) TMOE13(out, 1, r) } while (0)
#define DEC_M1(i_, out) do { const int qq_ = (i_); if (qq_ < 512) TMOE13(out, 1, qq_) else TMOE2(out, 1, qq_ - 512) } while (0)
#define CONV_RUN(first, end, step, DEC) do { const int e__ = (end), st__ = (step); int it__ = (first); if (it__ < e__) { TBlk cur__, nxt__; tbf4 v__[8]; float ks__[8]; DEC(it__, cur__); tb_load(cur__, v__, ks__, wave, lane); \
    for (; it__ < e__; it__ += st__) { __syncthreads(); tb_put(cur__, v__, ks__, scr, wave, lane); __syncthreads(); nxt__ = cur__; \
        if (it__ + st__ < e__) { DEC(it__ + st__, nxt__); tb_load(nxt__, v__, ks__, wave, lane); } tb_get(cur__, scr, wave, lane); cur__ = nxt__; } } } while (0)

__device__ __forceinline__ bool fill_slot(int nun, int G, int idx, int& slot, int& nslots) {
    const int rem = nun % G;
    if (rem == 0 || G - rem < G / 4) { slot = idx; nslots = G; return true; }
    if (idx < rem) return false;
    slot = idx - rem; nslots = G - rem; return true;
}
#define MOE13_BLOCK(L, q) { const int which_ = (q) >> 8, e_ = ((q) >> 4) & 15, kb_ = (q) & 15; const float* src_ = ((L) == 0 ? (which_ ? in[13] : in[12]) : (which_ ? in[29] : in[28])) + (size_t)e_ * 1024 * 256; \
    transpose_block<2>(src_, 256, 0, 1024, WB + ((L) == 0 ? WB_W13T0 : WB_W13T1) + (size_t)e_ * 512 * 1024, which_ * 128, kb_, 256, scr, tid, (L) == 0 ? in[7] : in[23]); }
#define MOE2_BLOCK(L, q2) { const int e_ = (q2) >> 4, kb_ = ((q2) >> 2) & 3, nb_ = (q2) & 3; const float* src_ = ((L) == 0 ? in[14] : in[30]) + (size_t)e_ * 256 * 1024; \
    transpose_block<0>(src_, 1024, 256 * nb_, 256, WB + ((L) == 0 ? WB_W2T0 : WB_W2T1) + (size_t)e_ * 1024 * 256, 256 * nb_, kb_, 256, scr, tid); }
constexpr int F8_BLOCKS = 224, F11_BLOCKS = 256;

namespace pg {
typedef short bf16x8 __attribute__((ext_vector_type(8)));
typedef float f32x4 __attribute__((ext_vector_type(4)));
typedef unsigned u32x4 __attribute__((ext_vector_type(4)));
constexpr int BM = 256, BK = 64, HALF = 128, HTB = HALF * BK * 2, STAGE_BYTES = 8 * HTB, NXCD = 8, WGM = 8;
__device__ __forceinline__ int lds_byte(int r, int c) { const int st = (r >> 4) * 2 + (c >> 5), rr = r & 15, cc = c & 31, ob = rr * 64 + cc * 2; return st * 1024 + (ob ^ (((ob >> 9) & 1) << 5)); }
__device__ __forceinline__ void stage_rc(int b, int& R, int& C) { const int st = b / 1024, sb = b % 1024, swz = sb ^ (((sb >> 9) & 1) << 5); R = (st >> 1) * 16 + swz / 64; C = (st & 1) * 32 + (swz % 64) / 2; }
__device__ __forceinline__ int perm32(int rho) { const int n = rho >> 4, i = rho & 15; return 8 * (i >> 2) + 4 * n + (i & 3); }
__device__ __forceinline__ const char* uptr(const char* p) { const unsigned long long v = (unsigned long long)p; const unsigned lo = __builtin_amdgcn_readfirstlane((unsigned)v), hi = __builtin_amdgcn_readfirstlane((unsigned)(v >> 32)); return (const char*)(((unsigned long long)hi << 32) | lo); }
__device__ __forceinline__ unsigned cvt_pk_bf16(float lo, float hi) { unsigned r; asm volatile("v_cvt_pk_bf16_f32 %0, %1, %2" : "=v"(r) : "v"(lo), "v"(hi)); return r; }
__device__ __forceinline__ u32x4 pack8(const f32x4& a, const f32x4& b) { u32x4 w; w.x = cvt_pk_bf16(a[0], a[1]); w.y = cvt_pk_bf16(a[2], a[3]); w.z = cvt_pk_bf16(b[0], b[1]); w.w = cvt_pk_bf16(b[2], b[3]); return w; }

struct TileOrder {
    int nM, nN, nwg, G, c;
    __device__ void init(int nM_, int nN_, int G_, int c_) { nM = nM_; nN = nN_; nwg = nM * nN; G = G_; c = c_; }
    __device__ bool get(int i, int& pm, int& pn) const {
        const long L = (long)i * G + c; if (L >= nwg) return false;
        int wgid = (int)L; { const int q = nwg / NXCD, r = nwg % NXCD, xcd = wgid % NXCD, off = wgid / NXCD; wgid = (xcd < r ? xcd * (q + 1) : r * (q + 1) + (xcd - r) * q) + off; }
        const int nig = WGM * nN, gid = wgid / nig, fm = gid * WGM, gsz = (nM % WGM == 0) ? WGM : (nM < WGM ? nM : ((nM - fm) < WGM ? (nM - fm) : WGM));
        pm = fm + ((wgid % nig) % gsz); pn = (wgid % nig) / gsz; return true;
    }
};
struct UnitD { int pm, pn; };
struct DenseSched {
    typedef UnitD U;
    const bf16* A; int lda; const bf16* Bt; int K; TileOrder ord;
    __device__ bool next(int i, U& u) const { return ord.get(i, u.pm, u.pn); }
    __device__ void uni(U& u) const { u.pm = __builtin_amdgcn_readfirstlane(u.pm); u.pn = __builtin_amdgcn_readfirstlane(u.pn); }
    __device__ const char* abase(const U& u) const { return (const char*)(A + (size_t)u.pm * BM * lda); }
    __device__ unsigned aoff(const U&, int r, int c) const { return (unsigned)(r * lda + c) * 2u; }
    __device__ const char* bbase(const U& u) const { return (const char*)(Bt + (size_t)u.pn * BM * K); }
    __device__ void done(const U&) const {}
};

template <class Epi, class Sched>
__device__ __forceinline__ void gemm_phase(LAS unsigned char* lds, const int K, const Sched& S, const Epi& E, const int ldb_ = 0) {
    int tid = threadIdx.x; asm volatile("" : "+v"(tid));
    const int wid = __builtin_amdgcn_readfirstlane(tid >> 6), lane = tid & 63, wr = wid >> 2, wc = wid & 3, fr = lane & 15, fq = lane >> 4;
    const int nt = K / BK;
    int R[2], C[2]; unsigned vb[2][2];
#pragma unroll
    for (int i = 0; i < 2; ++i) { stage_rc(tid * 16 + i * 8192, R[i], C[i]); const int Rb = (R[i] & ~31) + perm32(R[i] & 31);
        const int ldb = ldb_ ? ldb_ : K; vb[0][i] = (unsigned)(Rb * ldb + C[i]) * 2u; vb[1][i] = (unsigned)((HALF + Rb) * ldb + C[i]) * 2u; }
    const size_t kstep = (size_t)(BK * 2);
    const unsigned ldsw = (unsigned)wid * 1024u;
    const unsigned ldsbase = __builtin_amdgcn_readfirstlane((unsigned)(size_t)lds + ldsw);
    const int aoff = lds_byte(wr * 64 + fr, fq * 8), boff = lds_byte(wc * 32 + fr, fq * 8);
#define PG_SA(b, h) (((b) * 2 + (h)) * HTB)
#define PG_SB(b, h) ((4 + (b) * 2 + (h)) * HTB)
#define PG_STAGE(bufoff, gbase, voff) do { _Pragma("unroll") for (int _i = 0; _i < 2; ++_i) { unsigned _keep; \
        asm volatile("s_mov_b32 %0, m0\n\ts_mov_b32 m0, %3\n\ts_nop 0\n\tglobal_load_lds_dwordx4 %1, %2\n\ts_mov_b32 m0, %0" \
            : "=&s"(_keep) : "v"((voff)[_i]), "s"(gbase), "s"(ldsbase + (unsigned)((bufoff) + _i * 8192)) : "memory"); } } while (0)
#define PG_LDA(dst, b, h) do { _Pragma("unroll") for (int m = 0; m < 4; ++m) _Pragma("unroll") for (int k = 0; k < 2; ++k) dst[m][k] = *(const LAS bf16x8*)(lds + PG_SA(b, h) + aoff + m * 2048 + k * 1024); } while (0)
#define PG_LDB(dst, b, h) do { _Pragma("unroll") for (int n = 0; n < 2; ++n) _Pragma("unroll") for (int k = 0; k < 2; ++k) dst[n][k] = *(const LAS bf16x8*)(lds + PG_SB(b, h) + boff + n * 2048 + k * 1024); } while (0)
#define PG_MMA(ai, bj, At, Bt) do { __builtin_amdgcn_s_setprio(1); _Pragma("unroll") for (int m = 0; m < 4; ++m) _Pragma("unroll") for (int n = 0; n < 2; ++n) _Pragma("unroll") for (int k = 0; k < 2; ++k) \
        acc[ai][bj][m][n] = __builtin_amdgcn_mfma_f32_16x16x32_bf16(Bt[n][k], At[m][k], acc[ai][bj][m][n], 0, 0, 0); __builtin_amdgcn_s_setprio(0); } while (0)
#define PG_WAIT_V(n) asm volatile("s_waitcnt vmcnt(" #n ")" ::: "memory")
#define PG_WAIT_L(n) asm volatile("s_waitcnt lgkmcnt(" #n ")" ::: "memory")
#define PG_BAR __builtin_amdgcn_s_barrier()
#define PG_SCHED __builtin_amdgcn_sched_barrier(0)
    typename Sched::U cur, nxt; int ui = 0;
    if (!S.next(0, cur)) return;
    S.uni(cur);
    f32x4 acc[2][2][4][2];
#pragma unroll
    for (int a = 0; a < 2; ++a)
#pragma unroll
        for (int b = 0; b < 2; ++b)
#pragma unroll
            for (int m = 0; m < 4; ++m)
#pragma unroll
                for (int n = 0; n < 2; ++n) acc[a][b][m][n] = (f32x4){0.f, 0.f, 0.f, 0.f};
    bf16x8 At[4][2], B0[2][2], B1[2][2];
    const char* cA = uptr(S.abase(cur)); const char* cB = uptr(S.bbase(cur));
    unsigned va[2][2];
#pragma unroll
    for (int h = 0; h < 2; ++h)
#pragma unroll
        for (int i = 0; i < 2; ++i) va[h][i] = S.aoff(cur, h * HALF + R[i], C[i]);
    PG_STAGE(PG_SB(0, 0), cB, vb[0]); PG_STAGE(PG_SB(0, 1), cB, vb[1]); PG_STAGE(PG_SA(0, 0), cA, va[0]); PG_STAGE(PG_SA(0, 1), cA, va[1]);
    if (wr == 1) PG_BAR;
    PG_WAIT_V(2); PG_BAR;
    {   const char* cA1 = uptr(cA + kstep); const char* cB1 = uptr(cB + kstep);
        PG_STAGE(PG_SB(1, 0), cB1, vb[0]); PG_STAGE(PG_SA(1, 0), cA1, va[0]); PG_STAGE(PG_SB(1, 1), cB1, vb[1]); }
    PG_WAIT_V(6); PG_BAR;
    for (;;) {
        const bool has_next = __builtin_amdgcn_readfirstlane((int)S.next(ui + 1, nxt)) != 0;
        S.uni(nxt);
        const char* nA = uptr(has_next ? S.abase(nxt) : cA); const char* nB = uptr(has_next ? S.bbase(nxt) : cB);
        for (int t = 0; t < nt; t += 2) {
            const bool last = (t == nt - 2);
            const char* a1 = cA + (size_t)(t + 1) * kstep;
            const char* a2 = last ? nA : cA + (size_t)(t + 2) * kstep; const char* b2 = last ? nB : cB + (size_t)(t + 2) * kstep;
            const char* a3 = a2 + kstep; const char* b3 = b2 + kstep;
            a1 = uptr(a1); a2 = uptr(a2); b2 = uptr(b2); a3 = uptr(a3); b3 = uptr(b3);
            unsigned nva[2][2];
            if (last && has_next) {
#pragma unroll
                for (int h = 0; h < 2; ++h)
#pragma unroll
                    for (int i = 0; i < 2; ++i) nva[h][i] = S.aoff(nxt, h * HALF + R[i], C[i]);
            }
            PG_LDB(B0, 0, 0); PG_LDB(B1, 0, 1); PG_SCHED; PG_LDA(At, 0, 0); PG_STAGE(PG_SA(1, 1), a1, va[1]);
            PG_WAIT_V(8); PG_WAIT_L(0); PG_BAR; PG_MMA(0, 0, At, B0); PG_MMA(0, 1, At, B1); PG_BAR; PG_SCHED;
            if (last && has_next) {
#pragma unroll
                for (int h = 0; h < 2; ++h)
#pragma unroll
                    for (int i = 0; i < 2; ++i) va[h][i] = nva[h][i];
            }
            PG_LDA(At, 0, 1); PG_STAGE(PG_SB(0, 0), b2, vb[0]); PG_STAGE(PG_SB(0, 1), b2, vb[1]); PG_STAGE(PG_SA(0, 0), a2, va[0]);
            PG_WAIT_V(8); PG_WAIT_L(0); PG_BAR; PG_MMA(1, 0, At, B0); PG_MMA(1, 1, At, B1); PG_BAR; PG_SCHED;
            PG_LDB(B0, 1, 0); PG_LDB(B1, 1, 1); PG_SCHED; PG_LDA(At, 1, 0); PG_STAGE(PG_SA(0, 1), a2, va[1]);
            PG_WAIT_V(8); PG_WAIT_L(0); PG_BAR; PG_MMA(0, 0, At, B0); PG_MMA(0, 1, At, B1); PG_BAR; PG_SCHED;
            PG_LDA(At, 1, 1); PG_STAGE(PG_SB(1, 0), b3, vb[0]); PG_STAGE(PG_SB(1, 1), b3, vb[1]); PG_STAGE(PG_SA(1, 0), a3, va[0]);
            PG_WAIT_V(8); PG_WAIT_L(0); PG_BAR; PG_MMA(1, 0, At, B0); PG_MMA(1, 1, At, B1); PG_BAR; PG_SCHED;
        }
        if (wr == 0) PG_BAR;
        E(acc, cur, wr, wc, fr, fq);
        S.done(cur);
        if (!has_next) break;
#pragma unroll
        for (int a = 0; a < 2; ++a)
#pragma unroll
            for (int b = 0; b < 2; ++b)
#pragma unroll
                for (int m = 0; m < 4; ++m)
#pragma unroll
                    for (int n = 0; n < 2; ++n) acc[a][b][m][n] = (f32x4){0.f, 0.f, 0.f, 0.f};
        cur = nxt; cA = nA; cB = nB; ++ui;
        if (wr == 1) PG_BAR;
    }
    PG_WAIT_V(0);
    PG_BAR;
#undef PG_SA
#undef PG_SB
#undef PG_STAGE
#undef PG_LDA
#undef PG_LDB
#undef PG_MMA
#undef PG_WAIT_V
#undef PG_WAIT_L
#undef PG_BAR
#undef PG_SCHED
}
#define PG_FOREACH(acc, ...) _Pragma("unroll") for (int ai = 0; ai < 2; ++ai) _Pragma("unroll") for (int m = 0; m < 4; ++m) { const int rl = ai * 128 + wr * 64 + m * 16 + fr; \
    _Pragma("unroll") for (int bj = 0; bj < 2; ++bj) { const int cl = bj * 128 + wc * 32 + fq * 8; const f32x4 v0 = acc[ai][bj][m][0], v1 = acc[ai][bj][m][1]; __VA_ARGS__ } }

__device__ __forceinline__ void store_rot(bf16* headrow  , int d0, const f32x4& t0, const f32x4& t1  , const f32x4& v0, const f32x4& v1) {
    typedef unsigned u32x2 __attribute__((ext_vector_type(2)));
    u32x2 lo, hi;
    lo.x = cvt_pk_bf16(v0[0] * t0[0] - v1[0] * t0[1], v0[1] * t0[2] - v1[1] * t0[3]); lo.y = cvt_pk_bf16(v0[2] * t1[0] - v1[2] * t1[1], v0[3] * t1[2] - v1[3] * t1[3]);
    hi.x = cvt_pk_bf16(v1[0] * t0[0] + v0[0] * t0[1], v1[1] * t0[2] + v0[1] * t0[3]); hi.y = cvt_pk_bf16(v1[2] * t1[0] + v0[2] * t1[1], v1[3] * t1[2] + v0[3] * t1[3]);
    asm volatile("s_nop 1" ::: "memory");
    const auto rx = __builtin_amdgcn_permlane16_swap(lo.x, hi.x, false, false), ry = __builtin_amdgcn_permlane16_swap(lo.y, hi.y, false, false);
    const bool oddrow = ((threadIdx.x >> 4) & 1) != 0;
    u32x4 o; o.x = rx[0]; o.y = ry[0]; o.z = rx[1]; o.w = ry[1];
    *(u32x4*)(headrow + (oddrow ? 64 + d0 - 4 : d0)) = o;
}
struct EpiProj0 {
    bf16 *qkraw, *om, *qb, *kb; const float2* rot;
    __device__ __forceinline__ void operator()(const f32x4 (&acc)[2][2][4][2], const UnitD& u, int wr, int wc, int fr, int fq) const {
        if (u.pn >= 6) {
            const int d0 = 4 * (wc * 4 + fq); bf16* dst = u.pn < 8 ? qb : kb;
#pragma unroll
            for (int ai = 0; ai < 2; ++ai)
#pragma unroll
                for (int m = 0; m < 4; ++m) { const int row = u.pm * 256 + ai * 128 + wr * 64 + m * 16 + fr, b = row >> 11, s = row & 2047;
                    const f32x4 t0 = *(const f32x4*)(rot + s * 64 + d0), t1 = *(const f32x4*)(rot + s * 64 + d0 + 2);
#pragma unroll
                    for (int bj = 0; bj < 2; ++bj) { const int h = ((u.pn & 1) << 1) + bj; store_rot(dst + ((size_t)(b * 4 + h) * 2048 + s) * 128, d0, t0, t1, acc[ai][bj][m][0], acc[ai][bj][m][1]); } }
        } else {
        PG_FOREACH(acc, { const int row = u.pm * 256 + rl;
            if (u.pn < 4) *(u32x4*)(qkraw + (size_t)row * 1024 + u.pn * 256 + cl) = pack8(v0, v1);
            else *(u32x4*)(om + (size_t)row * 512 + (u.pn - 4) * 256 + cl) = pack8(v0, v1); }) }
    }
};
struct EpiVT0 {
    bf16 *vmt, *vbt;
    __device__ __forceinline__ void operator()(const f32x4 (&acc)[2][2][4][2], const UnitD& u, int wr, int wc, int fr, int fq) const {
        PG_FOREACH(acc, { const int c = u.pm * 256 + rl, cc = c & 511, h = cc >> 7, d = cc & 127, n = u.pn * 256 + cl, b = n >> 11, s = n & 2047;
            *(u32x4*)((c >> 9 ? vbt : vmt) + ((size_t)(b * 4 + h) * 128 + d) * 2048 + s) = pack8(v0, v1); })
    }
};
struct EpiProj1 {
    bf16 *q1, *kc, *vc, *ks, *kw; const float2* rot;
    __device__ __forceinline__ void operator()(const f32x4 (&acc)[2][2][4][2], const UnitD& u, int wr, int wc, int fr, int fq) const {
        if (u.pn >= 6) {
            const int d0 = 4 * (wc * 4 + fq); bf16* dst = u.pn == 6 ? ks : kw;
#pragma unroll
            for (int ai = 0; ai < 2; ++ai)
#pragma unroll
                for (int m = 0; m < 4; ++m) { const int row = u.pm * 256 + ai * 128 + wr * 64 + m * 16 + fr, b = row >> 11, s = row & 2047;
                    const f32x4 t0 = *(const f32x4*)(rot + s * 64 + d0), t1 = *(const f32x4*)(rot + s * 64 + d0 + 2);
#pragma unroll
                    for (int bj = 0; bj < 2; ++bj) store_rot(dst + ((size_t)(b * 2 + bj) * 2048 + s) * 128, d0, t0, t1, acc[ai][bj][m][0], acc[ai][bj][m][1]); }
        } else {
        PG_FOREACH(acc, { const int row = u.pm * 256 + rl, b = row >> 11, s = row & 2047;
            if (u.pn < 4) *(u32x4*)(q1 + ((size_t)(b * 8 + u.pn * 2 + (cl >> 7)) * 2048 + s) * 128 + (cl & 127)) = pack8(v0, v1);
            else *(u32x4*)((u.pn == 4 ? kc : vc) + ((size_t)(b * 2 + (cl >> 7)) * 2048 + s) * 128 + (cl & 127)) = pack8(v0, v1); }) }
    }
};
struct EpiVT1 {
    bf16 *vst, *vwt;
    __device__ __forceinline__ void operator()(const f32x4 (&acc)[2][2][4][2], const UnitD& u, int wr, int wc, int fr, int fq) const {
        PG_FOREACH(acc, { const int c = u.pm * 256 + rl, g = (c >> 7) & 1, d = c & 127, n = u.pn * 256 + cl, b = n >> 11, s = n & 2047;
            *(u32x4*)((c >> 8 ? vwt : vst) + ((size_t)(b * 2 + g) * 128 + d) * 2048 + s) = pack8(v0, v1); })
    }
};
template <bool IN_BF16>
struct EpiOut {
    const void* hin; bf16* hout;
    __device__ __forceinline__ void operator()(const f32x4 (&acc)[2][2][4][2], const UnitD& u, int wr, int wc, int fr, int fq) const {
        PG_FOREACH(acc, { const size_t o = (size_t)(u.pm * 256 + rl) * 1024 + u.pn * 256 + cl; f32x4 x0, x1;
            if (IN_BF16) { const u32x4 t = *(const u32x4*)((const bf16*)hin + o); x0 = (f32x4){lo16(t.x), hi16(t.x), lo16(t.y), hi16(t.y)}; x1 = (f32x4){lo16(t.z), hi16(t.z), lo16(t.w), hi16(t.w)}; }
            else { x0 = *(const f32x4*)((const float*)hin + o); x1 = *(const f32x4*)((const float*)hin + o + 4); }
            *(u32x4*)(hout + o) = pack8(x0 + v0, x1 + v1); })
    }
};
constexpr int MOE_TAB_OFF = LDSCTL_OFF + 1024;
struct UnitM { int e, mt, pn, tile; };
template <int NPN>
struct MoeOrder {
    int G, vcu; const LAS int* pre;
    __device__ bool get(int i, UnitM& u) const {
        const int L = i * G + vcu, tile = L / NPN; if (tile >= __builtin_amdgcn_readfirstlane(pre[16])) return false;
        int e = 0;
#pragma unroll
        for (int q = 1; q < 16; ++q) e += (tile >= __builtin_amdgcn_readfirstlane(pre[q])) ? 1 : 0;
        u.e = e; u.mt = tile - __builtin_amdgcn_readfirstlane(pre[e]); u.pn = L % NPN; u.tile = tile; return true;
    }
};
struct MoeSched1 {
    typedef UnitM U;
    const bf16* XN; const bf16* W13T; const int* cnt; const uint2* list; MoeOrder<2> ord; unsigned* pub;
    __device__ bool next(int i, U& u) const { return ord.get(i, u); }
    __device__ void done(const U& u) const { if (pub) { asm volatile("s_waitcnt vmcnt(0) lgkmcnt(0)\n\ts_barrier" ::: "memory");
            if (threadIdx.x == 0) { __builtin_amdgcn_fence(__ATOMIC_RELEASE, "agent"); (void)__hip_atomic_fetch_add(pub + u.tile * 32, 1u, __ATOMIC_RELAXED, __HIP_MEMORY_SCOPE_AGENT); } } }
    __device__ void uni(U& u) const { u.e = __builtin_amdgcn_readfirstlane(u.e); u.mt = __builtin_amdgcn_readfirstlane(u.mt); u.pn = __builtin_amdgcn_readfirstlane(u.pn); u.tile = __builtin_amdgcn_readfirstlane(u.tile); }
    __device__ const char* abase(const U&) const { return (const char*)XN; }
    __device__ unsigned aoff(const U& u, int r, int c) const { const int idx = u.mt * 256 + r; const int tok = idx < cnt[u.e * 32] ? (int)(list[u.e * T_ + idx].x >> 1) : 0; return (unsigned)(tok * 1024 + c) * 2u; }
    __device__ const char* bbase(const U& u) const { return (const char*)(W13T + ((size_t)u.e * 512 + u.pn * 256) * 1024); }
};
struct MoeSched2 {
    typedef UnitM U;
    const bf16* H; const bf16* W2T; MoeOrder<4> ord;
    const unsigned* sub; int ubase, ucount, busy, nfree, rot;
    __device__ bool next(int i, U& u) const {
        if (!sub) return ord.get(i, u);
        int k = ord.vcu - busy; if (k < 0) return false;
        k -= rot; if (k < 0) k += nfree;
        const int j = i * nfree + k; if (j >= ucount) return false;
        const int L = ubase + j, tile = L >> 2;
        int e = 0;
#pragma unroll
        for (int q = 1; q < 16; ++q) e += (tile >= __builtin_amdgcn_readfirstlane(ord.pre[q])) ? 1 : 0;
        u.e = e; u.mt = tile - __builtin_amdgcn_readfirstlane(ord.pre[e]); u.pn = L & 3; u.tile = tile;
        if ((threadIdx.x >> 6) == 0) { unsigned sp = 0;
            while (__hip_atomic_load(sub + tile * 32, __ATOMIC_RELAXED, __HIP_MEMORY_SCOPE_AGENT) < 2u) { __builtin_amdgcn_s_sleep(8); if (++sp > (1u << 20)) break; } }
        asm volatile("s_waitcnt vmcnt(0) lgkmcnt(0)\n\ts_barrier" ::: "memory");
        return true;
    }
    __device__ void uni(U& u) const { u.e = __builtin_amdgcn_readfirstlane(u.e); u.mt = __builtin_amdgcn_readfirstlane(u.mt); u.pn = __builtin_amdgcn_readfirstlane(u.pn); u.tile = __builtin_amdgcn_readfirstlane(u.tile); }
    __device__ const char* abase(const U& u) const { return (const char*)(H + (size_t)u.tile * 256 * 256); }
    __device__ unsigned aoff(const U&, int r, int c) const { return (unsigned)(r * 256 + c) * 2u; }
    __device__ const char* bbase(const U& u) const { return (const char*)(W2T + ((size_t)u.e * 1024 + u.pn * 256) * 256); }
    __device__ void done(const U&) const {}
};
struct EpiMoe1 {
    bf16* H; const int* cnt; const float* listr;
    __device__ __forceinline__ void operator()(const f32x4 (&acc)[2][2][4][2], const UnitM& u, int wr, int wc, int fr, int fq) const {
        const int ne = cnt[u.e * 32];
        float rs[8];
#pragma unroll
        for (int q = 0; q < 8; ++q) { const int idx = u.mt * 256 + (q >> 2) * 128 + wr * 64 + (q & 3) * 16 + fr; rs[q] = idx < ne ? listr[u.e * T_ + idx] : 0.f; }
#pragma unroll
        for (int ai = 0; ai < 2; ++ai)
#pragma unroll
            for (int m = 0; m < 4; ++m) { const int rl = ai * 128 + wr * 64 + m * 16 + fr; const float r = rs[ai * 4 + m]; f32x4 h[2];
#pragma unroll
                for (int n = 0; n < 2; ++n)
#pragma unroll
                    for (int j = 0; j < 4; ++j) { const float a = r * acc[ai][0][m][n][j], b = r * acc[ai][1][m][n][j]; h[n][j] = a * b * __builtin_amdgcn_rcpf(1.f + __expf(-a)); }
                *(u32x4*)(H + ((size_t)u.tile * 256 + rl) * 256 + u.pn * 128 + wc * 32 + fq * 8) = pack8(h[0], h[1]); }
    }
};
struct EpiMoe2 {
    const int* cnt; const uint2* liste; bf16* ys0; bf16* ys1; const bf16* hres;
    __device__ __forceinline__ void operator()(const f32x4 (&acc)[2][2][4][2], const UnitM& u, int wr, int wc, int fr, int fq) const {
        const int ne = cnt[u.e * 32];
        int ent[8]; float w[8];
#pragma unroll
        for (int q = 0; q < 8; ++q) { const int idx = u.mt * 256 + (q >> 2) * 128 + wr * 64 + (q & 3) * 16 + fr; const bool ok = idx < ne;
            uint2 t_ = make_uint2(0xffffffffu, 0u); if (ok) t_ = liste[u.e * T_ + idx]; ent[q] = (int)t_.x; w[q] = __uint_as_float(t_.y); }
        const unsigned colo = (unsigned)(u.pn * 256 + wc * 32 + fq * 8);
#pragma unroll
        for (int hf = 0; hf < 2; ++hf) {
            u32x4 hr[4][2];
#pragma unroll
            for (int qq = 0; qq < 4; ++qq) { const int q = hf * 4 + qq; const bool s0 = ent[q] >= 0 && !(ent[q] & 1);
#pragma unroll
                for (int bj = 0; bj < 2; ++bj) hr[qq][bj] = s0 ? *(const u32x4*)(hres + (unsigned)((ent[q] >> 1) * 1024) + colo + bj * 128) : (u32x4){0u, 0u, 0u, 0u}; }
#pragma unroll
            for (int qq = 0; qq < 4; ++qq) { const int q = hf * 4 + qq, ai = q >> 2, m = q & 3;
                if (ent[q] >= 0) { const unsigned off = (unsigned)(((ent[q] & 1) * T_ + (ent[q] >> 1)) * 1024) + colo;
#pragma unroll
                    for (int bj = 0; bj < 2; ++bj) { const u32x4 t = hr[qq][bj];
                        const f32x4 r0 = {lo16(t.x), hi16(t.x), lo16(t.y), hi16(t.y)}, r1 = {lo16(t.z), hi16(t.z), lo16(t.w), hi16(t.w)};
                        *(u32x4*)(ys0 + off + bj * 128) = pack8(acc[ai][bj][m][0] * w[q] + r0, acc[ai][bj][m][1] * w[q] + r1); } } }
            asm volatile("" ::: "memory"); }
    }
};
struct UnitC { int kv, pm, ks; };
struct CmpSched {
    typedef UnitC U;
    const bf16* KC; const bf16* VC; const bf16* WK; const bf16* WV; int G, c;
    __device__ bool next(int i, U& u) const { const int L = i * G + c; if (L >= 64) return false; u.kv = L >> 5; u.pm = (L >> 2) & 7; u.ks = L & 3; return true; }
    __device__ void uni(U& u) const { u.kv = __builtin_amdgcn_readfirstlane(u.kv); u.pm = __builtin_amdgcn_readfirstlane(u.pm); u.ks = __builtin_amdgcn_readfirstlane(u.ks); }
    __device__ const char* abase(const U& u) const { return (const char*)((u.kv ? VC : KC) + (size_t)u.pm * 256 * 2048 + u.ks * 1024); }
    __device__ unsigned aoff(const U&, int r, int c) const { return (unsigned)(r * 2048 + c) * 2u; }
    __device__ const char* bbase(const U& u) const { return (const char*)((u.kv ? WV : WK) + u.ks * 1024); }
    __device__ void done(const U&) const {}
};
struct EpiCmp1 {
    bf16* part;
    __device__ __forceinline__ void operator()(const f32x4 (&acc)[2][2][4][2], const UnitC& u, int wr, int wc, int fr, int fq) const {
        bf16* base = part + ((size_t)(u.ks * 2 + u.kv) * 2048 + u.pm * 256) * 256;
        PG_FOREACH(acc, { *(u32x4*)(base + (size_t)rl * 256 + cl) = pack8(v0, v1); })
    }
};
}

namespace at {
typedef short bf16x8 __attribute__((ext_vector_type(8)));
typedef short s16x4 __attribute__((ext_vector_type(4)));
typedef float f32x16 __attribute__((ext_vector_type(16)));
typedef unsigned u32x4 __attribute__((ext_vector_type(4)));
typedef unsigned u32x2 __attribute__((ext_vector_type(2)));
#define DI __device__ __forceinline__
#define AT_MFMA(a, b, c) __builtin_amdgcn_mfma_f32_32x32x16_bf16((a), (b), (c), 0, 0, 0)
constexpr int KPITCH = 272, VPITCH = 136, KBYTES = 64 * KPITCH, VBYTES = 128 * VPITCH, GOFF = KBYTES + VBYTES, BUFB = GOFF + 256;
constexpr int XOFF = 2 * BUFB;
constexpr float SC2 = 0.08838834764831845f * 1.4426950408889634f;
constexpr float LOG2E = 1.4426950408889634f;

DI float vmax3(float a, float b, float c) { float r; asm("v_max3_f32 %0, %1, %2, %3" : "=v"(r) : "v"(a), "v"(b), "v"(c)); return r; }
DI bf16x8 pack_step(const f32x16& x, int s) {
    u32x4 p;
    asm volatile("s_nop 0\n\tv_cvt_pk_bf16_f32 %0, %4, %5\n\tv_cvt_pk_bf16_f32 %1, %6, %7\n\tv_cvt_pk_bf16_f32 %2, %8, %9\n\tv_cvt_pk_bf16_f32 %3, %10, %11\n\ts_nop 1"
                 : "=&v"(p[0]), "=&v"(p[1]), "=&v"(p[2]), "=&v"(p[3])
                 : "v"(x[8 * s]), "v"(x[8 * s + 1]), "v"(x[8 * s + 2]), "v"(x[8 * s + 3]), "v"(x[8 * s + 4]), "v"(x[8 * s + 5]), "v"(x[8 * s + 6]), "v"(x[8 * s + 7]));
    return __builtin_bit_cast(bf16x8, p);
}
DI void zero4(f32x16 (&o)[4]) {
#pragma unroll
    for (int d = 0; d < 4; ++d)
#pragma unroll
        for (int i = 0; i < 16; ++i) o[d][i] = 0.f; }
DI void load_q(bf16x8 (&q)[8], const bf16* qrows  , int c, int h) {
#pragma unroll
    for (int ks = 0; ks < 8; ++ks) q[ks] = *(const bf16x8*)(qrows + c * 128 + 16 * ks + 8 * h); }
DI void rot_q(bf16x8 (&q)[8], const float2* rot, int pos, int h) {
#pragma unroll
    for (int ks = 0; ks < 4; ++ks) { u32x4 lo, hi; const u32x4 a = __builtin_bit_cast(u32x4, q[ks]), b = __builtin_bit_cast(u32x4, q[ks + 4]);
#pragma unroll
        for (int jj = 0; jj < 4; ++jj) { const float4 t = *(const float4*)(rot + pos * 64 + 16 * ks + 8 * h + 2 * jj);
            const float x0 = lo16(a[jj]), x1 = hi16(a[jj]), y0 = lo16(b[jj]), y1 = hi16(b[jj]);
            lo[jj] = pk2(x0 * t.x - y0 * t.y, x1 * t.z - y1 * t.w); hi[jj] = pk2(y0 * t.x + x0 * t.y, y1 * t.z + x1 * t.w); }
        q[ks] = __builtin_bit_cast(bf16x8, lo); q[ks + 4] = __builtin_bit_cast(bf16x8, hi); }
}
struct Stage { u32x4 k[2]; u32x4 v[2]; float g; };
DI void stage_load(Stage& s, const bf16* kt, const bf16* vt, int vpitch, const float* li, const float* bc, int tid) {
#pragma unroll
    for (int p = 0; p < 2; ++p) { const int idx = p * 512 + tid; s.k[p] = *(const u32x4*)(kt + idx * 8); s.v[p] = *(const u32x4*)(vt + (size_t)(idx >> 3) * vpitch + (idx & 7) * 8); }
    s.g = 0.f; if (li && tid < 64) s.g = (li[tid] - bc[tid]) * LOG2E;
}
DI void stage_write(const Stage& s, LAS unsigned char* buf, bool hasg, int tid) {
#pragma unroll
    for (int p = 0; p < 2; ++p) { const int idx = p * 512 + tid;
        *(LAS u32x4*)(buf + (idx >> 4) * KPITCH + (idx & 15) * 16) = s.k[p];
        LAS unsigned char* d = buf + KBYTES + (idx >> 3) * VPITCH + (idx & 7) * 16;
        u32x2 lo; lo.x = s.v[p].x; lo.y = s.v[p].y; u32x2 hi; hi.x = s.v[p].z; hi.y = s.v[p].w;
        *(LAS u32x2*)d = lo; *(LAS u32x2*)(d + 8) = hi; }
    if (hasg && tid < 64) *(LAS float*)(buf + GOFF + tid * 4) = s.g;
}
DI void s_tile(f32x16 (&st)[2], const bf16x8 (&q)[8], const LAS unsigned char* kbuf, int r, int h) {
    bf16x8 a[2][8];
#pragma unroll
    for (int t = 0; t < 2; ++t)
#pragma unroll
        for (int ks = 0; ks < 8; ++ks) a[t][ks] = *(const LAS bf16x8*)(kbuf + (32 * t + r) * KPITCH + (16 * ks + 8 * h) * 2);
#pragma unroll
    for (int t = 0; t < 2; ++t) { f32x16 acc;
#pragma unroll
        for (int i = 0; i < 16; ++i) acc[i] = 0.f;
#pragma unroll
        for (int ks = 0; ks < 8; ++ks) acc = AT_MFMA(a[t][ks], q[ks], acc);
        st[t] = acc; }
}
DI void s_tile_asm(f32x16 (&st)[2], const bf16x8 (&q)[8], const LAS unsigned char* kbuf, int r, int h) {
    static_assert(KPITCH == 272, "offsets below assume the 272-byte K pitch");
    const unsigned a = (unsigned)(size_t)(kbuf + r * KPITCH + 16 * h);
    bf16x8 f0, f1, f2, f3, f4, f5, f6, f7; f32x16 c0, c1;
    asm volatile(
        "ds_read_b128 %[f0], %[a] offset:0\n\t"
        "ds_read_b128 %[f1], %[a] offset:32\n\t"
        "ds_read_b128 %[f2], %[a] offset:64\n\t"
        "ds_read_b128 %[f3], %[a] offset:96\n\t"
        "ds_read_b128 %[f4], %[a] offset:128\n\t"
        "ds_read_b128 %[f5], %[a] offset:160\n\t"
        "ds_read_b128 %[f6], %[a] offset:192\n\t"
        "ds_read_b128 %[f7], %[a] offset:224\n\t"
        "s_waitcnt lgkmcnt(7)\n\t"
        "v_mfma_f32_32x32x16_bf16 %[c0], %[f0], %[q0], 0\n\t"
        "ds_read_b128 %[f0], %[a] offset:8704\n\t"
        "s_waitcnt lgkmcnt(7)\n\t"
        "v_mfma_f32_32x32x16_bf16 %[c0], %[f1], %[q1], %[c0]\n\t"
        "ds_read_b128 %[f1], %[a] offset:8736\n\t"
        "s_waitcnt lgkmcnt(7)\n\t"
        "v_mfma_f32_32x32x16_bf16 %[c0], %[f2], %[q2], %[c0]\n\t"
        "ds_read_b128 %[f2], %[a] offset:8768\n\t"
        "s_waitcnt lgkmcnt(7)\n\t"
        "v_mfma_f32_32x32x16_bf16 %[c0], %[f3], %[q3], %[c0]\n\t"
        "ds_read_b128 %[f3], %[a] offset:8800\n\t"
        "s_waitcnt lgkmcnt(7)\n\t"
        "v_mfma_f32_32x32x16_bf16 %[c0], %[f4], %[q4], %[c0]\n\t"
        "ds_read_b128 %[f4], %[a] offset:8832\n\t"
        "s_waitcnt lgkmcnt(7)\n\t"
        "v_mfma_f32_32x32x16_bf16 %[c0], %[f5], %[q5], %[c0]\n\t"
        "ds_read_b128 %[f5], %[a] offset:8864\n\t"
        "s_waitcnt lgkmcnt(7)\n\t"
        "v_mfma_f32_32x32x16_bf16 %[c0], %[f6], %[q6], %[c0]\n\t"
        "ds_read_b128 %[f6], %[a] offset:8896\n\t"
        "s_waitcnt lgkmcnt(7)\n\t"
        "v_mfma_f32_32x32x16_bf16 %[c0], %[f7], %[q7], %[c0]\n\t"
        "ds_read_b128 %[f7], %[a] offset:8928\n\t"
        "s_waitcnt lgkmcnt(7)\n\t"
        "v_mfma_f32_32x32x16_bf16 %[c1], %[f0], %[q0], 0\n\t"
        "s_waitcnt lgkmcnt(6)\n\t"
        "v_mfma_f32_32x32x16_bf16 %[c1], %[f1], %[q1], %[c1]\n\t"
        "s_waitcnt lgkmcnt(5)\n\t"
        "v_mfma_f32_32x32x16_bf16 %[c1], %[f2], %[q2], %[c1]\n\t"
        "s_waitcnt lgkmcnt(4)\n\t"
        "v_mfma_f32_32x32x16_bf16 %[c1], %[f3], %[q3], %[c1]\n\t"
        "s_waitcnt lgkmcnt(3)\n\t"
        "v_mfma_f32_32x32x16_bf16 %[c1], %[f4], %[q4], %[c1]\n\t"
        "s_waitcnt lgkmcnt(2)\n\t"
        "v_mfma_f32_32x32x16_bf16 %[c1], %[f5], %[q5], %[c1]\n\t"
        "s_waitcnt lgkmcnt(1)\n\t"
        "v_mfma_f32_32x32x16_bf16 %[c1], %[f6], %[q6], %[c1]\n\t"
        "s_waitcnt lgkmcnt(0)\n\t"
        "v_mfma_f32_32x32x16_bf16 %[c1], %[f7], %[q7], %[c1]\n\t"
        "s_nop 15\n\t"
        "s_nop 7"
        : [c0] "=&v"(c0), [c1] "=&v"(c1), [f0] "=&v"(f0), [f1] "=&v"(f1), [f2] "=&v"(f2), [f3] "=&v"(f3), [f4] "=&v"(f4), [f5] "=&v"(f5), [f6] "=&v"(f6), [f7] "=&v"(f7)
        : [a] "v"(a), [q0] "v"(q[0]), [q1] "v"(q[1]), [q2] "v"(q[2]), [q3] "v"(q[3]), [q4] "v"(q[4]), [q5] "v"(q[5]), [q6] "v"(q[6]), [q7] "v"(q[7])
        : "memory");
    st[0] = c0; st[1] = c1;
}
DI void s_tile_h(f32x16 (&st)[2], const bf16x8 (&q)[8], const LAS unsigned char* kbuf, int r, int h) {
#pragma unroll
    for (int t = 0; t < 2; ++t) { bf16x8 a[8];
#pragma unroll
        for (int ks = 0; ks < 8; ++ks) a[ks] = *(const LAS bf16x8*)(kbuf + (32 * t + r) * KPITCH + (16 * ks + 8 * h) * 2);
        f32x16 acc;
#pragma unroll
        for (int i = 0; i < 16; ++i) acc[i] = 0.f;
#pragma unroll
        for (int ks = 0; ks < 8; ++ks) acc = AT_MFMA(a[ks], q[ks], acc);
        st[t] = acc; asm volatile("" ::: "memory"); }
}
DI void pv_frags(s16x4 (&f)[8], const LAS unsigned char* vbuf, int t, int s, int r, int h) {
#pragma unroll
    for (int dt = 0; dt < 4; ++dt) { const LAS unsigned char* a = vbuf + (32 * dt + r) * VPITCH + (32 * t + 16 * s + 4 * h) * 2; f[2 * dt] = *(const LAS s16x4*)a; f[2 * dt + 1] = *(const LAS s16x4*)(a + 16); }
}
DI void pv_tile(f32x16 (&ot)[4], const f32x16 (&p)[2], const LAS unsigned char* vbuf, int r, int h) {
    s16x4 fa[8], fb[8];
    pv_frags(fa, vbuf, 0, 0, r, h);
#pragma unroll
    for (int step = 0; step < 4; ++step) { const int t = step >> 1, s = step & 1;
        if (step < 3) { if (step & 1) pv_frags(fa, vbuf, (step + 1) >> 1, (step + 1) & 1, r, h); else pv_frags(fb, vbuf, (step + 1) >> 1, (step + 1) & 1, r, h); }
        const bf16x8 pb = pack_step(p[t], s);
#pragma unroll
        for (int dt = 0; dt < 4; ++dt) { const s16x4 lo = (step & 1) ? fb[2 * dt] : fa[2 * dt], hi = (step & 1) ? fb[2 * dt + 1] : fa[2 * dt + 1];
            ot[dt] = AT_MFMA(__builtin_shufflevector(lo, hi, 0, 1, 2, 3, 4, 5, 6, 7), pb, ot[dt]); } }
}
#define AT_KL(t, i) (32 * (t) + ((i) & 3) + 8 * ((i) >> 2) + 4 * h)
#define AT_SOFTMAX(st, ot, m, l, VALID) do { float tm_ = -1e30f; \
    _Pragma("unroll") for (int t = 0; t < 2; ++t) _Pragma("unroll") for (int i = 0; i < 16; ++i) { const int kl = AT_KL(t, i); if (VALID) tm_ = fmaxf(tm_, st[t][i]); } \
    tm_ = fmaxf(tm_, __shfl_xor(tm_, 32)); \
    const float mn_ = fmaxf(m, tm_ * at::SC2), al_ = __builtin_amdgcn_exp2f(m - mn_); m = mn_; l *= al_; \
    if (!__all(al_ == 1.f)) { _Pragma("unroll") for (int d = 0; d < 4; ++d) _Pragma("unroll") for (int i = 0; i < 16; ++i) ot[d][i] *= al_; } \
    _Pragma("unroll") for (int t = 0; t < 2; ++t) _Pragma("unroll") for (int i = 0; i < 16; ++i) { const int kl = AT_KL(t, i); \
        const float p_ = (VALID) ? __builtin_amdgcn_exp2f(st[t][i] * at::SC2 - mn_) : 0.f; st[t][i] = p_; l += p_; } } while (0)
#define AT_SOFTMAX2(st, ot, m, l, MINE, INTERIOR, VALIDPOS) do { \
    if (!(INTERIOR)) { _Pragma("unroll") for (int t = 0; t < 2; ++t) _Pragma("unroll") for (int i = 0; i < 16; ++i) { const int kl = AT_KL(t, i); st[t][i] = (VALIDPOS) ? st[t][i] : -1e30f; } } \
    float tm_ = at::vmax3(st[0][0], st[0][1], st[1][0]); tm_ = at::vmax3(tm_, st[1][1], st[0][2]); tm_ = at::vmax3(tm_, st[0][3], st[1][2]); \
    _Pragma("unroll") for (int i = 4; i < 16; i += 2) { tm_ = at::vmax3(tm_, st[0][i], st[0][i + 1]); tm_ = at::vmax3(tm_, st[1][i - 1], st[1][i]); } \
    tm_ = at::vmax3(tm_, st[1][15], st[1][15]); { const auto r_ = __builtin_amdgcn_permlane32_swap(__float_as_uint(tm_), __float_as_uint(tm_), false, false); tm_ = at::vmax3(__uint_as_float(r_[0]), __uint_as_float(r_[1]), tm_); } \
    const bool mine_ = (MINE) && (tm_ > -1e29f); const float ts_ = tm_ * at::SC2; \
      \
    const float mn_ = (mine_ && ts_ > m + 8.f) ? ts_ : m, al_ = __builtin_amdgcn_exp2f(m - mn_); m = mn_; l *= al_; \
    if (!__all(al_ == 1.f)) { _Pragma("unroll") for (int d = 0; d < 4; ++d) ot[d] *= al_; } \
    const float mb_ = mine_ ? -mn_ : -1e30f; float l2_ = 0.f; \
    _Pragma("unroll") for (int i = 0; i < 16; ++i) { const float p0_ = __builtin_amdgcn_exp2f(__builtin_fmaf(st[0][i], at::SC2, mb_)), p1_ = __builtin_amdgcn_exp2f(__builtin_fmaf(st[1][i], at::SC2, mb_)); st[0][i] = p0_; st[1][i] = p1_; l += p0_; l2_ += p1_; } \
    l += l2_; } while (0)
DI void store_pair16(bf16* p, u32x2 a  , u32x2 b  , int h) {
    const auto r0 = __builtin_amdgcn_permlane32_swap(a.x, b.x, false, false), r1 = __builtin_amdgcn_permlane32_swap(a.y, b.y, false, false);
    u32x4 o; o.x = r0[0]; o.y = r1[0]; o.z = r0[1]; o.w = r1[1];
    *(u32x4*)(p + 8 * h) = o;
}
DI void store_ot(const f32x16 (&ot)[4], float scale, bf16* yrow  , int h) {
#pragma unroll
    for (int dt = 0; dt < 4; ++dt)
#pragma unroll
        for (int g = 0; g < 4; g += 2) { u32x2 w[2];
#pragma unroll
            for (int k = 0; k < 2; ++k) { w[k].x = pk2(ot[dt][4 * (g + k)] * scale, ot[dt][4 * (g + k) + 1] * scale); w[k].y = pk2(ot[dt][4 * (g + k) + 2] * scale, ot[dt][4 * (g + k) + 3] * scale); }
            store_pair16(yrow + 32 * dt + 8 * g, w[0], w[1], h); }
}

DI void ypk_set(u32x2 (&y)[4][4], const f32x16 (&ot)[4], float sc) {
#pragma unroll
    for (int dt = 0; dt < 4; ++dt)
#pragma unroll
        for (int g = 0; g < 4; ++g) { y[dt][g].x = pk2(ot[dt][4 * g] * sc, ot[dt][4 * g + 1] * sc); y[dt][g].y = pk2(ot[dt][4 * g + 2] * sc, ot[dt][4 * g + 3] * sc); } }
DI void ypk_add(u32x2 (&y)[4][4], const f32x16 (&ot)[4], float sc) {
#pragma unroll
    for (int dt = 0; dt < 4; ++dt)
#pragma unroll
        for (int g = 0; g < 4; ++g) { const u32x2 o = y[dt][g];
            y[dt][g].x = pk2(lo16(o.x) + ot[dt][4 * g] * sc, hi16(o.x) + ot[dt][4 * g + 1] * sc); y[dt][g].y = pk2(lo16(o.y) + ot[dt][4 * g + 2] * sc, hi16(o.y) + ot[dt][4 * g + 3] * sc); } }
DI void ypk_store(const u32x2 (&y)[4][4], bf16* yrow, int h) {
#pragma unroll
    for (int dt = 0; dt < 4; ++dt)
#pragma unroll
        for (int g = 0; g < 4; ++g) *(u32x2*)(yrow + 32 * dt + 8 * g + 4 * h) = y[dt][g]; }
DI void accum_ot(const f32x16 (&ot)[4], float scale, bf16* yrow, int h) {
#pragma unroll
    for (int dt = 0; dt < 4; ++dt)
#pragma unroll
        for (int g = 0; g < 4; ++g) { bf16* p = yrow + 32 * dt + 8 * g + 4 * h; const u32x2 o = *(const u32x2*)p;
            u32x2 w; w.x = pk2(lo16(o.x) + ot[dt][4 * g] * scale, hi16(o.x) + ot[dt][4 * g + 1] * scale); w.y = pk2(lo16(o.y) + ot[dt][4 * g + 2] * scale, hi16(o.y) + ot[dt][4 * g + 3] * scale);
            *(u32x2*)p = w; }
}

DI void mlstm_unit(int bh, int qb, LAS unsigned char* lds, const bf16* QM, const bf16* KM, const bf16* VMT, const float* LI, const float* BC, const bf16* OM, const float* gain, bf16* Y0) {
    int tid = threadIdx.x; asm volatile("" : "+v"(tid));
    const int w = __builtin_amdgcn_readfirstlane(tid >> 6), lane = tid & 63, c = lane & 31, h = lane >> 5, r = c;
    const int q0 = qb * 256 + w * 32, q = q0 + c;
    bf16x8 qf[8]; load_q(qf, QM + ((size_t)bh * 2048 + q0) * 128, c, h);
    const float bq2 = BC[bh * 2048 + q] * LOG2E - 3.5f;
    f32x16 ot[4]; zero4(ot); float den = 0.f;
    const bf16* kbase = KM + (size_t)bh * 2048 * 128; const bf16* vbase = VMT + (size_t)bh * 128 * 2048;
    const float* li = LI + bh * 2048; const float* bc = BC + bh * 2048;
    const int ntiles = 4 * qb + 4;
    Stage sg; stage_load(sg, kbase, vbase, 2048, li, bc, tid); stage_write(sg, lds, true, tid);
    if (ntiles > 1) stage_load(sg, kbase + (size_t)64 * 128, vbase + 64, 2048, li + 64, bc + 64, tid);
    __syncthreads();
    for (int i = 0; i < ntiles; ++i) {
        LAS unsigned char* buf = lds + (i & 1) * BUFB;
        if (i + 1 < ntiles) stage_write(sg, lds + ((i + 1) & 1) * BUFB, true, tid);
        if (i + 2 < ntiles) stage_load(sg, kbase + (size_t)(i + 2) * 64 * 128, vbase + (i + 2) * 64, 2048, li + (i + 2) * 64, bc + (i + 2) * 64, tid);
        if (i * 64 <= q0 + 31) {
            f32x16 st[2]; s_tile_asm(st, qf, buf, r, h);
            typedef float f4v __attribute__((ext_vector_type(4)));
            const LAS float* gk = (const LAS float*)(buf + GOFF);
            const bool interior = i * 64 + 63 <= q0;
            float den2 = 0.f;
#pragma unroll
            for (int t = 0; t < 2; ++t) { f4v gv[4];
#pragma unroll
                for (int g = 0; g < 4; ++g) gv[g] = *(const LAS f4v*)(gk + 32 * t + 8 * g + 4 * h);
                if (interior) {
#pragma unroll
                    for (int e = 0; e < 16; e += 2) { const float p0 = st[t][e] * __builtin_amdgcn_exp2f(bq2 + gv[e >> 2][e & 3]), p1 = st[t][e + 1] * __builtin_amdgcn_exp2f(bq2 + gv[e >> 2][(e & 3) + 1]);
                        st[t][e] = p0; st[t][e + 1] = p1; den += p0; den2 += p1; }
                } else {
#pragma unroll
                    for (int e = 0; e < 16; ++e) { const int kl = AT_KL(t, e); const float pv = st[t][e] * __builtin_amdgcn_exp2f(bq2 + gv[e >> 2][e & 3]);
                        const float p = (i * 64 + kl <= q) ? pv : 0.f; st[t][e] = p; den += p; }
                } }
            den += den2;
            pv_tile(ot, st, buf + KBYTES, r, h);
        }
        __syncthreads();
    }
    den += __shfl_xor(den, 32);
    const float inv = 1.f / fmaxf(fabsf(den), 1.f);
    float ss = 0.f;
#pragma unroll
    for (int d = 0; d < 4; ++d)
#pragma unroll
        for (int e = 0; e < 16; ++e) { ot[d][e] *= inv; ss += ot[d][e] * ot[d][e]; }
    ss += __shfl_xor(ss, 32);
    const float rn = rsqrtf(ss * (1.f / 128.f) + 1e-6f);
    const int b = bh >> 2, hh = bh & 3; const size_t m = (size_t)b * 2048 + q;
#pragma unroll
    for (int dt = 0; dt < 4; ++dt)
#pragma unroll
        for (int g2 = 0; g2 < 4; g2 += 2) { u32x2 wv[2];
#pragma unroll
            for (int k = 0; k < 2; ++k) { const int g = g2 + k, d0 = 32 * dt + 8 * g + 4 * h, col = hh * 128 + d0;
                const float4 gg = *(const float4*)(gain + col); const uint2 oo = *(const uint2*)(OM + m * 512 + col);
                const float y0 = ot[dt][4 * g] * rn * gg.x * sigmoidf_(lo16(oo.x)), y1 = ot[dt][4 * g + 1] * rn * gg.y * sigmoidf_(hi16(oo.x));
                const float y2 = ot[dt][4 * g + 2] * rn * gg.z * sigmoidf_(lo16(oo.y)), y3 = ot[dt][4 * g + 3] * rn * gg.w * sigmoidf_(hi16(oo.y));
                wv[k].x = pk2(y0, y1); wv[k].y = pk2(y2, y3); }
            store_pair16(Y0 + m * 1024 + hh * 128 + 32 * dt + 8 * g2, wv[0], wv[1], h); }
}

DI void moba_unit(int bh, int cur, LAS unsigned char* lds, const bf16* QB, const bf16* KB, const bf16* VBT, const float* KMEAN, bf16* Y0) {
    int tid = threadIdx.x; asm volatile("" : "+v"(tid));
    const int w = __builtin_amdgcn_readfirstlane(tid >> 6), lane = tid & 63, c = lane & 31, h = lane >> 5, r = c;
    const int q0 = cur * 256 + w * 32, q = q0 + c;
    bf16x8 qf[8]; load_q(qf, QB + ((size_t)bh * 2048 + q0) * 128, c, h);
    LAS float* km = (LAS float*)(lds + XOFF); LAS unsigned* uni = (LAS unsigned*)(lds + XOFF + 4096);
    for (int i = tid; i < 1024; i += 512) km[i] = KMEAN[bh * 1024 + i];
    if (tid == 0) uni[0] = 0u;
    __syncthreads();
    float gv[7];
#pragma unroll
    for (int j = 0; j < 7; ++j) gv[j] = 0.f;
#pragma unroll
    for (int ks = 0; ks < 8; ++ks) { float qv[8];
#pragma unroll
        for (int e = 0; e < 8; ++e) qv[e] = bf2f((bf16)qf[ks][e]);
#pragma unroll
        for (int j = 0; j < 7; ++j) { if (j < cur) { const LAS float* kp = km + j * 128 + 16 * ks + 8 * h;
#pragma unroll
                for (int e = 0; e < 8; ++e) gv[j] += qv[e] * kp[e]; } } }
    unsigned sel = 0u;
#pragma unroll
    for (int j = 0; j < 7; ++j) { gv[j] += __shfl_xor(gv[j], 32); if (j >= cur) gv[j] = NEGINF; }
#pragma unroll
    for (int rnd = 0; rnd < 3; ++rnd) { float best = -3e38f; int bi = 0;
#pragma unroll
        for (int j = 0; j < 7; ++j) { const bool tk = !((sel >> j) & 1u) && gv[j] > best; best = tk ? gv[j] : best; bi = tk ? j : bi; }
        if (best > 0.5f * NEGINF) sel |= 1u << bi; }
    {   unsigned u = sel;
#pragma unroll
        for (int o = 32; o > 0; o >>= 1) u |= __shfl_xor(u, o);
        if (lane == 0) atomicOr((unsigned*)uni, u); }
    __syncthreads();
    const unsigned need = uni[0] | (1u << cur);
    f32x16 ot[4]; zero4(ot); float m = -1e30f, l = 0.f;
    const bf16* kbase = KB + (size_t)bh * 2048 * 128; const bf16* vbase = VBT + (size_t)bh * 128 * 2048;
    int tcur = 4 * (__ffs(need) - 1); unsigned rem = need;
#define MOBA_NEXT(t) { int n_ = (t) + 1; if ((n_ & 3) == 0) { rem &= rem - 1; n_ = rem ? 4 * (__ffs(rem) - 1) : -1; } (t) = n_; }
    Stage sg; stage_load(sg, kbase + (size_t)tcur * 64 * 128, vbase + tcur * 64, 2048, nullptr, nullptr, tid); stage_write(sg, lds, false, tid);
    int tn = tcur; MOBA_NEXT(tn)
    if (tn >= 0) stage_load(sg, kbase + (size_t)tn * 64 * 128, vbase + tn * 64, 2048, nullptr, nullptr, tid);
    __syncthreads();
    int bsel = 0;
    while (tcur >= 0) {
        int tn2 = tn; if (tn2 >= 0) MOBA_NEXT(tn2)
        LAS unsigned char* buf = lds + bsel * BUFB;
        if (tn >= 0) stage_write(sg, lds + (bsel ^ 1) * BUFB, false, tid);
        if (tn2 >= 0) stage_load(sg, kbase + (size_t)tn2 * 64 * 128, vbase + tn2 * 64, 2048, nullptr, nullptr, tid);
        const int blk = tcur >> 2; const bool own = blk == cur;
        const bool mine = own ? true : (((sel >> blk) & 1u) != 0u);
        const bool wave_needs = own ? (tcur * 64 <= q0 + 31) : (__ballot(mine) != 0ull);
        if (wave_needs) {
            f32x16 st[2]; s_tile_asm(st, qf, buf, r, h);
            const int k0 = tcur * 64;
            AT_SOFTMAX2(st, ot, m, l, mine, (k0 + 63 <= q0), (k0 + kl <= q));
            pv_tile(ot, st, buf + KBYTES, r, h);
        }
        __syncthreads();
        tcur = tn; tn = tn2; bsel ^= 1;
    }
#undef MOBA_NEXT
    l += __shfl_xor(l, 32);
    const float inv = 1.f / fmaxf(l, 1e-30f);
    const int b = bh >> 2, hh = bh & 3; const size_t mrow = (size_t)b * 2048 + q;
    store_ot(ot, inv, Y0 + mrow * 1024 + 512 + hh * 128, h);
}

DI void nsa_unit(int bg, int qt, LAS unsigned char* lds, const bf16* Q1, const float2* ROT, const bf16* KCMP, const bf16* VCMPT, const bf16* KS, const bf16* VST, const bf16* KW, const bf16* VWT, const float* G, bf16* Y1) {
    int tid = threadIdx.x; asm volatile("" : "+v"(tid));
    const int w = __builtin_amdgcn_readfirstlane(tid >> 6), lane = tid & 63, c = lane & 31, h = lane >> 5, r = c;
    const int b = bg >> 1, hd = (bg & 1) * 4 + (w >> 1), qi = 32 * (w & 1) + c, s = qt * 64 + qi;
    const size_t qrow0 = ((size_t)(b * 8 + hd) * 2048 + qt * 64 + 32 * (w & 1)) * 128;
    const size_t mrow = (size_t)b * 2048 + s;
    LAS float* imp = (LAS float*)(lds + XOFF);
    LAS unsigned* msk = (LAS unsigned*)(lds + XOFF + 67584);
    LAS unsigned char* ylds = lds + XOFF + ((w * 32 + c) * 264) + 8 * h;
    if (tid == 0) msk[64] = 0u;
    f32x16 ot[4];
    bf16x8 qf[8];
    LAS float* gpark = (LAS float*)(lds + XOFF + 67584 + 512) + tid;
    const unsigned goff = ((unsigned)(b * 2048 + s) * 24u + (unsigned)hd * 3u) * 4u;
    const float g0 = *(const float*)((const char*)G + goff);
    {   load_q(qf, Q1 + qrow0, c, h);
        Stage sa, sb;
        stage_load(sa, KCMP + (size_t)bg * 128 * 128, VCMPT + (size_t)bg * 128 * 128, 128, nullptr, nullptr, tid);
        stage_load(sb, KCMP + (size_t)bg * 128 * 128 + 64 * 128, VCMPT + (size_t)bg * 128 * 128 + 64, 128, nullptr, nullptr, tid);
        stage_write(sa, lds, false, tid); stage_write(sb, lds + BUFB, false, tid);
        __syncthreads();
        f32x16 sA[2], sB[2]; s_tile_asm(sA, qf, lds, r, h); s_tile_asm(sB, qf, lds + BUFB, r, h);
        float mx = -1e30f;
#pragma unroll
        for (int t = 0; t < 2; ++t)
#pragma unroll
            for (int e = 0; e < 16; ++e) { const int n0 = AT_KL(t, e), n1 = 64 + n0; if (16 * n0 + 31 <= s) mx = fmaxf(mx, sA[t][e]); if (n1 < 127 && 16 * n1 + 31 <= s) mx = fmaxf(mx, sB[t][e]); }
        mx = fmaxf(mx, __shfl_xor(mx, 32)) * SC2;
        float l = 0.f;
#pragma unroll
        for (int t = 0; t < 2; ++t)
#pragma unroll
            for (int e = 0; e < 16; ++e) { const int n0 = AT_KL(t, e), n1 = 64 + n0;
                const float pa = (16 * n0 + 31 <= s) ? __builtin_amdgcn_exp2f(sA[t][e] * SC2 - mx) : 0.f, pb = (n1 < 127 && 16 * n1 + 31 <= s) ? __builtin_amdgcn_exp2f(sB[t][e] * SC2 - mx) : 0.f;
                sA[t][e] = pa; sB[t][e] = pb; l += pa + pb; }
        l += __shfl_xor(l, 32);
        const float inv = 1.f / fmaxf(l, 1e-30f);
#pragma unroll
        for (int t = 0; t < 2; ++t)
#pragma unroll
            for (int e = 0; e < 16; ++e) { sA[t][e] *= inv; sB[t][e] *= inv; }
        {   LAS float* slab = imp + (w * 32 + c) * 32;
            float pA[2][4], pB[2][4];
#pragma unroll
            for (int t = 0; t < 2; ++t)
#pragma unroll
                for (int g = 0; g < 4; ++g) { pA[t][g] = __shfl_xor(sA[t][4 * g + 3], 32); pB[t][g] = __shfl_xor(sB[t][4 * g + 3], 32); }
#pragma unroll
            for (int t = 0; t < 2; ++t)
#pragma unroll
                for (int g = 0; g < 4; ++g) {
                    const float ra = (sA[t][4 * g] + sA[t][4 * g + 1]) + (sA[t][4 * g + 2] + sA[t][4 * g + 3]), rb = (sB[t][4 * g] + sB[t][4 * g + 1]) + (sB[t][4 * g + 2] + sB[t][4 * g + 3]);
                    const float prevA0 = g > 0 ? pA[t][g > 0 ? g - 1 : 0] : (t > 0 ? pA[0][3] : 0.f);
                    const float prevB0 = g > 0 ? pB[t][g > 0 ? g - 1 : 0] : (t > 0 ? pB[0][3] : pA[1][3]);
                    const float prevA = h ? pA[t][g] : prevA0, prevB = h ? pB[t][g] : prevB0;
                    slab[8 * t + 2 * g + h] = ra + prevA; slab[16 + 8 * t + 2 * g + h] = rb + prevB; } }
        zero4(ot);
        pv_tile(ot, sA, lds + KBYTES, r, h); pv_tile(ot, sB, lds + BUFB + KBYTES, r, h);
    }
    __syncthreads();
    {   const int cur = qt, j = lane & 31, hf = lane >> 5;
        volatile LAS float* vb = (volatile LAS float*)(lds + XOFF + 67584 + 512) + (w * 2 + hf) * 32;
        for (int k = 0; k < 4; ++k) { const int qq = 8 * w + 2 * k + hf;
            const bool forced = (j == 0) || (j == cur) || (j == cur - 1);
            const LAS float* ip = imp + (((qq >> 5) * 32) + (qq & 31)) * 32 + j;
            const float im = (ip[0] + ip[2 * 32 * 32]) + (ip[4 * 32 * 32] + ip[6 * 32 * 32]);
            const float val = (j <= cur) ? (forced ? 1e4f : im) : NEGINF;
            vb[j] = val;
            int rank = 0;
#pragma unroll
            for (int i = 0; i < 32; ++i) { const float vi = vb[i]; rank += ((vi > val) || (vi == val && i < j)) ? 1 : 0; }
            const bool selb = (rank < 8) && (val > 0.5f * NEGINF);
            const unsigned long long bal = __ballot(selb);
            const unsigned mk = hf ? (unsigned)(bal >> 32) : (unsigned)bal;
            if (j == 0) { msk[qq] = mk; atomicOr((unsigned*)(msk + 64), mk); } }
    }
    __syncthreads();
    const unsigned mymask = msk[qi]; const unsigned uni = msk[64];
    { const float g1_ = *(const float*)((const char*)G + goff + 4u), g2_ = *(const float*)((const char*)G + goff + 8u); gpark[0] = g1_; gpark[512] = g2_; }
    {
#pragma unroll
        for (int dt = 0; dt < 4; ++dt)
#pragma unroll
            for (int g = 0; g < 4; ++g) { u32x2 wv; wv.x = pk2(ot[dt][4 * g] * g0, ot[dt][4 * g + 1] * g0); wv.y = pk2(ot[dt][4 * g + 2] * g0, ot[dt][4 * g + 3] * g0); *(LAS u32x2*)(ylds + (32 * dt + 8 * g) * 2) = wv; } }
    const int q0pos = qt * 64 + 32 * (w & 1);
    rot_q(qf, ROT, s, h);
    {   zero4(ot); float m = -1e30f, l = 0.f;
        const bf16* kbase = KS + (size_t)bg * 2048 * 128; const bf16* vbase = VST + (size_t)bg * 128 * 2048;
        unsigned rem = uni; int tcur = __ffs(rem) - 1; rem &= rem - 1;
        Stage sg; stage_load(sg, kbase + (size_t)tcur * 64 * 128, vbase + tcur * 64, 2048, nullptr, nullptr, tid); stage_write(sg, lds, false, tid);
        int tn = rem ? (__ffs(rem) - 1) : -1; rem &= rem - 1;
        if (tn >= 0) stage_load(sg, kbase + (size_t)tn * 64 * 128, vbase + tn * 64, 2048, nullptr, nullptr, tid);
        __syncthreads();
        int bsel = 0;
        while (tcur >= 0) {
            const int tn2 = rem ? (__ffs(rem) - 1) : -1; rem &= rem - 1;
            LAS unsigned char* buf = lds + bsel * BUFB;
            if (tn >= 0) stage_write(sg, lds + (bsel ^ 1) * BUFB, false, tid);
            if (tn2 >= 0) stage_load(sg, kbase + (size_t)tn2 * 64 * 128, vbase + tn2 * 64, 2048, nullptr, nullptr, tid);
            const bool mine = ((mymask >> tcur) & 1u) != 0u;
            if (__ballot(mine) != 0ull && tcur * 64 <= q0pos + 31) {
                f32x16 st[2]; s_tile_asm(st, qf, buf, r, h);
                const int k0 = tcur * 64;
                AT_SOFTMAX2(st, ot, m, l, mine, (k0 + 63 <= q0pos), (k0 + kl <= s));
                pv_tile(ot, st, buf + KBYTES, r, h);
            }
            __syncthreads();
            tcur = tn; tn = tn2; bsel ^= 1;
        }
        l += __shfl_xor(l, 32);
        {   const float sc = gpark[0] / fmaxf(l, 1e-30f);
#pragma unroll
            for (int dt = 0; dt < 4; ++dt)
#pragma unroll
                for (int g = 0; g < 4; ++g) { LAS u32x2* p = (LAS u32x2*)(ylds + (32 * dt + 8 * g) * 2); const u32x2 o = *p; u32x2 wv;
                    wv.x = pk2(lo16(o.x) + ot[dt][4 * g] * sc, hi16(o.x) + ot[dt][4 * g + 1] * sc); wv.y = pk2(lo16(o.y) + ot[dt][4 * g + 2] * sc, hi16(o.y) + ot[dt][4 * g + 3] * sc); *p = wv; } }
    }
    {   zero4(ot); float m = -1e30f, l = 0.f;
        const bf16* kbase = KW + (size_t)bg * 2048 * 128; const bf16* vbase = VWT + (size_t)bg * 128 * 2048;
        const int t0 = qt >= 8 ? qt - 8 : 0;
        Stage sg; stage_load(sg, kbase + (size_t)t0 * 64 * 128, vbase + t0 * 64, 2048, nullptr, nullptr, tid); stage_write(sg, lds, false, tid);
        if (t0 < qt) stage_load(sg, kbase + (size_t)(t0 + 1) * 64 * 128, vbase + (t0 + 1) * 64, 2048, nullptr, nullptr, tid);
        __syncthreads();
        for (int tcur = t0; tcur <= qt; ++tcur) {
            LAS unsigned char* buf = lds + ((tcur - t0) & 1) * BUFB;
            if (tcur < qt) stage_write(sg, lds + ((tcur + 1 - t0) & 1) * BUFB, false, tid);
            if (tcur + 1 < qt) stage_load(sg, kbase + (size_t)(tcur + 2) * 64 * 128, vbase + (tcur + 2) * 64, 2048, nullptr, nullptr, tid);
            if (tcur * 64 <= q0pos + 31 && tcur * 64 + 63 + 512 > q0pos) {
                f32x16 st[2]; s_tile_asm(st, qf, buf, r, h);
                const int k0 = tcur * 64;
                AT_SOFTMAX2(st, ot, m, l, true, (k0 + 63 <= q0pos && q0pos + 31 - k0 < 512), ((k0 + kl <= s) && (s - (k0 + kl) < 512)));
                pv_tile(ot, st, buf + KBYTES, r, h);
            }
            __syncthreads();
        }
        l += __shfl_xor(l, 32);
        {   const float sc = gpark[512] / fmaxf(l, 1e-30f); bf16* yrow = Y1 + ((size_t)b * 2048 + s) * 1024 + hd * 128;
#pragma unroll
            for (int dt = 0; dt < 4; ++dt)
#pragma unroll
                for (int g2 = 0; g2 < 4; g2 += 2) { u32x2 wv[2];
#pragma unroll
                    for (int k = 0; k < 2; ++k) { const int g = g2 + k; const u32x2 o = *(const LAS u32x2*)(ylds + (32 * dt + 8 * g) * 2);
                        wv[k].x = pk2(lo16(o.x) + ot[dt][4 * g] * sc, hi16(o.x) + ot[dt][4 * g + 1] * sc); wv[k].y = pk2(lo16(o.y) + ot[dt][4 * g + 2] * sc, hi16(o.y) + ot[dt][4 * g + 3] * sc); }
                    store_pair16(yrow + 32 * dt + 8 * g2, wv[0], wv[1], h); } }
    }
}
#undef DI
}

struct Args { const float* in[32]; float* out; unsigned char* ws; int ph_lo, ph_hi; };
constexpr int N_PHASES = 20;

__device__ __forceinline__ bool ph_in(int k) { const Args __attribute__((address_space(4)))* ap = (const Args __attribute__((address_space(4)))*)__builtin_amdgcn_kernarg_segment_ptr(); asm volatile("" : "+s"(ap)); return ap->ph_lo <= k && k < ap->ph_hi; }
#define INL(layer, k) ((layer) == 0 ? in[7 + (k)] : in[23 + (k)])
#define MOE_BLOCK(layer, pb) do { \
        if (IN(pb)) for (int rep_ = 0; rep_ < NREP(pb); ++rep_) { PTRS; int* cnt = ctl + CW_CNT + 512 * (layer); \
            LAS float* Wl = (LAS float*)lds; \
            stage_aux<20, 20>(Wl, INL(layer, 1), 4, 4, INL(layer, 3), 16, tid); \
            __syncthreads(); \
            LAS int* recs = (LAS int*)(lds + 122880); LAS int* lcnt = (LAS int*)(lds + 127008); LAS int* lbase = lcnt + 16; \
            if (tid < 16) lcnt[tid] = 0; \
            __syncthreads(); \
            RouteArgs a{}; a.h = HB; a.gain = INL(layer, 0); a.bg = INL(layer, 2); a.be = INL(layer, 4); a.cnt = cnt; a.list = LIST; a.listw = LISTW; _Pragma("unroll") for (int j_ = 0; j_ < 4; ++j_) a.g[j_] = *(const float4*)(a.gain + j_ * 256 + lane * 4); \
            int nrec = 0; \
            _Pragma("nounroll") for (int r = gw; r < T_ && nrec < 16; r += 2 * NGW) { RowRaw ra_, rb_; const bool two = (r + NGW < T_) && (nrec + 1 < 16); row_load(ra_, a.h, (const bf16*)nullptr, (const bf16*)nullptr, r, lane); if (two) row_load(rb_, a.h, (const bf16*)nullptr, (const bf16*)nullptr, r + NGW, lane); \
                if (two) { route_row2(a, r, r + NGW, lane, (volatile float*)(lds + 120000) + wave * 64, Wl, (volatile LAS int*)(recs + (wave * 16 + nrec) * 8), (volatile LAS int*)(recs + (wave * 16 + nrec + 1) * 8), lcnt, ra_, rb_); nrec += 2; } \
                else { route_row(a, r, lane, (volatile float*)(lds + 120000) + wave * 64, Wl, (volatile LAS int*)(recs + (wave * 16 + nrec) * 8), lcnt, ra_); ++nrec; } } \
            if (lane == 0) lcnt[32 + wave] = nrec; \
            __syncthreads(); \
            if (tid < 16) lbase[tid] = atomicAdd(&cnt[tid * 32], lcnt[tid]); \
            __syncthreads(); \
            if (tid < 256) { const int wv = tid >> 5, rr = (tid >> 1) & 15, kk = tid & 1; const LAS int* rc = recs + (wv * 16 + rr) * 8; \
                if (rr < lcnt[32 + wv]) { const int e = rc[1 + kk], pos = lbase[e] + rc[3 + kk]; LISTE[e * T_ + pos] = make_uint2((unsigned)((rc[0] << 1) | kk), (unsigned)rc[5 + kk]);        LISTR[e * T_ + pos] = ((const LAS float*)rc)[7]; } } \
            __syncthreads(); \
            if ((layer) == 0) { LAS float* scr = (LAS float*)lds; bf16* WB = (bf16*)(ws + WS_WB); CONV_RUN((int)blockIdx.x, 256, G, DEC_W2T0); }        \
        } \
        SEAM(pb); \
        if (IN(pb + 1)) for (int rep_ = 0; rep_ < NREP(pb + 1); ++rep_) { PTRS; int* cnt = ctl + CW_CNT + 512 * (layer); \
            LAS int* pre = (LAS int*)(lds + pg::MOE_TAB_OFF); \
            if (tid == 0) { int acc_ = 0; for (int e = 0; e < 16; ++e) { pre[e] = acc_; acc_ += (cnt[e * 32] + 255) >> 8; } pre[16] = acc_; } \
            __syncthreads(); \
            pg::MoeSched1 S; S.XN = HB; S.W13T = (const bf16*)(ws + WS_WB) + ((layer) == 0 ? WB_W13T0 : WB_W13T1); S.cnt = cnt; S.list = LISTE; S.ord.G = G; S.ord.vcu = vcu; S.ord.pre = pre; \
            S.pub = (unsigned*)ctl + CW_DONE + 8192 * (layer); \
            pg::EpiMoe1 E{H, cnt, LISTR}; \
            pg::gemm_phase<pg::EpiMoe1, pg::MoeSched1>((LAS unsigned char*)lds, 1024, S, E); \
            {         \
                const int ntile_ = __builtin_amdgcn_readfirstlane(pre[16]), nm1_ = 2 * ntile_, rounds_ = (nm1_ + G - 1) / G, rem_ = nm1_ - (rounds_ - 1) * G; \
                const int busy_ = rem_ < G ? rem_ : 0; int te_ = rem_ < G ? ((rounds_ - 1) * G) / 2 : ntile_; if (te_ > ntile_) te_ = ntile_; \
                const int nfree_ = G - busy_, e3_ = (4 * te_) % nfree_, nlate_ = 4 * (ntile_ - te_); \
                pg::MoeSched2 S2; S2.H = H; S2.W2T = (const bf16*)(ws + WS_WB) + ((layer) == 0 ? WB_W2T0 : WB_W2T1); S2.ord.G = G; S2.ord.vcu = vcu; S2.ord.pre = pre; S2.sub = (const unsigned*)ctl + CW_DONE + 8192 * (layer); \
                S2.busy = busy_; S2.nfree = nfree_; \
                pg::EpiMoe2 E2{cnt, LISTE, YS0, YS1, HB}; \
                S2.ubase = 0; S2.ucount = 4 * te_; S2.rot = 0;                                     \
                pg::gemm_phase<pg::EpiMoe2, pg::MoeSched2>((LAS unsigned char*)lds, 256, S2, E2); \
                S2.ubase = 4 * te_; S2.ucount = nlate_; S2.rot = e3_;                            \
                pg::gemm_phase<pg::EpiMoe2, pg::MoeSched2>((LAS unsigned char*)lds, 256, S2, E2); \
                if ((layer) == 0) {         \
                    const int k_ = vcu - busy_, lo_ = e3_ + nlate_; int slot = -1, ns = nfree_ - lo_; \
                    if (ns >= G / 4) { if (k_ >= lo_) slot = k_ - lo_; } else { slot = vcu; ns = G; } \
                    if (slot >= 0) { LAS float* scr = (LAS float*)lds; bf16* WB = (bf16*)(ws + WS_WB); CONV_RUN(slot, 160 + 64 + 128 + F8_BLOCKS, ns, DEC_P7); } } } \
        } \
        SEAM(pb + 2); \
        if (IN(pb + 3)) for (int rep_ = 0; rep_ < NREP(pb + 3); ++rep_) { PTRS; int* cnt = ctl + CW_CNT + 512 * (layer); \
            RowNormArgs a{}; a.baseh = YS0; a.add0 = YS1; a.add1 = nullptr;        \
            if (layer == 0) { LAS float* Wl = (LAS float*)lds; stage_aux<24, 28>(Wl, in[16] + 2560, 2584, 24, in[16], 2584, tid); __syncthreads(); \
                a.hout = YS0; a.gain = in[15]; _Pragma("unroll") for (int j_ = 0; j_ < 4; ++j_) a.g[j_] = *(const float4*)(a.gain + j_ * 256 + lane * 4); a.xn = XN; a.auxAct = 1; a.auxOut = Gt;     \
                _Pragma("nounroll") for (int r = gw; r < T_; r += 2 * NGW) { RowRaw ra_, rb_; const bool two = r + NGW < T_; row_load(ra_, a.baseh, a.add0, a.add1, r, lane); if (two) row_load(rb_, a.baseh, a.add0, a.add1, r + NGW, lane); \
                    if (two) rownorm_row2<24, 28>(a, r, r + NGW, lane, Wl, ra_, rb_); else rownorm_row<24, 28>(a, r, lane, Wl, ra_); } } \
            else { a.gain = in[31]; _Pragma("unroll") for (int j_ = 0; j_ < 4; ++j_) a.g[j_] = *(const float4*)(a.gain + j_ * 256 + lane * 4); a.fout = hbuf; \
                _Pragma("nounroll") for (int r = gw; r < T_; r += 2 * NGW) { RowRaw ra_, rb_; const bool two = r + NGW < T_; row_load(ra_, a.baseh, a.add0, a.add1, r, lane); if (two) row_load(rb_, a.baseh, a.add0, a.add1, r + NGW, lane); \
                    rownorm_row<0, 4>(a, r, lane, (const LAS float*)lds, ra_); if (two) rownorm_row<0, 4>(a, r + NGW, lane, (const LAS float*)lds, rb_); } } \
        } \
        if (layer == 0) SEAM(pb + 3); \
    } while (0)
__global__ void __launch_bounds__(512, 2) mk_fwd(Args args) {
    extern __shared__ __attribute__((aligned(16))) unsigned char lds[];
    typedef const Args __attribute__((address_space(4)))* KArgP;
#define in AP->in
    for (int u = threadIdx.x; u < (LDS_BYTES - LDSCTL_OFF) / 4; u += 512) ((LAS unsigned*)(lds + LDSCTL_OFF))[u] = 0u;
    __syncthreads();
    (void)xcd_barrier_post((unsigned*)(args.ws + WS_CTL) + CW_BAR, (volatile LAS unsigned*)(lds + MISC_OFF) + 8);
#ifndef PHMASK
#define PHMASK 0xFFFFFu
#endif
#ifndef REPMASK
#define REPMASK 0u
#endif
#define NREP(k) ((((REPMASK) >> (k)) & 1u) ? 2 : 1)
#define IN(k) (((PHMASK >> (k)) & 1u) && ph_in(k))
#define SEAM2(k, k2) do { if (IN(k) && IN(k2)) { KArgP AB = (KArgP)__builtin_amdgcn_kernarg_segment_ptr(); asm volatile("" : "+s"(AB)); \
        XcdBarrier bar_; bar_.bar = (unsigned*)(AB->ws + WS_CTL) + CW_BAR; bar_.x = xb_xcc_id(); bar_.st = (volatile LAS unsigned*)(lds + MISC_OFF) + 8; xcd_barrier(bar_); } } while (0)
#define SEAM(k) SEAM2(k, (k) + 1)

#define PTRS \
    KArgP AP = (KArgP)__builtin_amdgcn_kernarg_segment_ptr(); asm volatile("" : "+s"(AP)); \
    int tid = threadIdx.x; asm volatile("" : "+v"(tid)); const int lane = tid & 63; const size_t gtid = (size_t)blockIdx.x * 512 + tid; (void)lane; (void)gtid; \
    const int wave = __builtin_amdgcn_readfirstlane(tid >> 6); const int G = gridDim.x, gw = blockIdx.x * 8 + wave, NGW = G * 8; const size_t NGT = (size_t)G * 512; (void)gw; (void)NGW; (void)NGT; \
    const int vcu = (G % 8 == 0) ? ((int)blockIdx.x % 8) * (G / 8) + (int)blockIdx.x / 8 : (int)blockIdx.x; (void)vcu; \
    int* ctl = (int*)(AP->ws + WS_CTL); (void)ctl; float* ldsf = (float*)lds; (void)ldsf; \
    volatile float* wq = (volatile float*)(lds + 32768) + wave * 256; volatile float* wp = wq + 128; (void)wq; (void)wp; \
    unsigned char* ws = AP->ws; float* hbuf = AP->out; \
    bf16* XN = (bf16*)(ws + WS_R0); \
    unsigned char* sm = ws + WS_SM; \
    float* IFr = (float*)(sm + SM_IF); float* LI = (float*)(sm + SM_LI); float* BC = (float*)(sm + SM_BC); \
    int* LIST = (int*)(sm + SM_LIST); float* LISTW = (float*)(sm + SM_LISTW); (void)LIST; (void)LISTW; uint2* LISTE = (uint2*)(sm + SM_LIST); (void)LISTE; float* LISTR = (float*)(sm + SM_LISTR); (void)LISTR; unsigned* SELM = (unsigned*)(sm + SM_SELM); float* Gt = (float*)(sm + SM_G); \
    bf16* HC = (bf16*)(sm + SM_HC); bf16* KCMP = (bf16*)(sm + SM_KCMP); bf16* VCMPT = (bf16*)(sm + SM_VCMPT); (void)HC; \
    float2* ROT = (float2*)(sm + SM_ROT); float* CB = (float*)(sm + SM_CB); float* PART = (float*)(ws + WS_R3); (void)ROT; (void)CB; (void)PART; \
    bf16* QKraw = (bf16*)(ws + WS_R1); bf16* OM = (bf16*)(ws + WS_R2); bf16* QB = (bf16*)(ws + WS_R2 + 16 * MiB); \
    bf16* KB = (bf16*)(ws + WS_R3); bf16* VMT = (bf16*)(ws + WS_R3 + 16 * MiB); bf16* VBT = (bf16*)(ws + WS_R4); \
    bf16* QM = (bf16*)(ws + WS_R0); bf16* KM = (bf16*)(ws + WS_R0 + 16 * MiB); \
    bf16* Y0 = (bf16*)(ws + WS_R1); \
    bf16* Q1 = (bf16*)(ws + WS_R1); bf16* Q1R = (bf16*)(ws + WS_R2); bf16* OC = (bf16*)(ws + WS_R3); \
    bf16* KC = (bf16*)(ws + WS_R4); bf16* VC = (bf16*)(ws + WS_R4 + 8 * MiB); bf16* KS = (bf16*)(ws + WS_R4 + 16 * MiB); bf16* KW = (bf16*)(ws + WS_R4 + 24 * MiB); \
    bf16* VST = (bf16*)(ws + WS_R5); bf16* VWT = (bf16*)(ws + WS_R5 + 8 * MiB); \
    bf16* Y1 = (bf16*)(ws + WS_R0); \
    bf16* H = (bf16*)(ws + WS_R1); bf16* YS0 = (bf16*)(ws + WS_R2); bf16* YS1 = (bf16*)(ws + WS_R3); bf16* HB = (bf16*)(ws + WS_R4); (void)HB; \
    (void)0
    if (IN(0)) for (int rep_ = 0; rep_ < NREP(0); ++rep_) { PTRS;
        LAS float* Wl = (LAS float*)lds;
        __syncthreads();
        stage_aux<8, 12>(Wl, in[2] + 2048, 3592, 8, in[2], 3592, tid);
        __syncthreads();
        RowNormArgs a{}; a.base = in[0]; a.gain = in[1]; a.xn = XN; a.auxAct = 0; a.auxOut = IFr;
#pragma unroll
        for (int j_ = 0; j_ < 4; ++j_) a.g[j_] = *(const float4*)(a.gain + j_ * 256 + lane * 4);
#pragma nounroll
        for (int r = gw; r < T_; r += 2 * NGW) { RowRaw ra_, rb_; const bool two = r + NGW < T_; row_load(ra_, a.base, (const bf16*)nullptr, (const bf16*)nullptr, r, lane); if (two) row_load(rb_, a.base, (const bf16*)nullptr, (const bf16*)nullptr, r + NGW, lane);
            if (two) rownorm_row2<8, 12>(a, r, r + NGW, lane, Wl, ra_, rb_); else rownorm_row<8, 12>(a, r, lane, Wl, ra_); }
        __syncthreads();
        for (size_t i = gtid; i < (size_t)2048 * 64; i += NGT) { const int pos = (int)(i >> 6), fi = (int)(i & 63);
            const float ang = (float)pos * __builtin_amdgcn_exp2f(-(float)fi * (13.287712379549449f / 64.f));
            ROT[i] = make_float2(__cosf(ang), __sinf(ang)); }
        LAS float* scr = (LAS float*)lds;
        bf16* WB = (bf16*)(ws + WS_WB);
        CONV_RUN((int)blockIdx.x, 224, G, DEC_P0);
    }
    SEAM(0);
#ifdef XBAR_TEST
    for (int xb_ = 0; xb_ < 20; ++xb_) { SEAM(0); }
#endif
    if (IN(1)) for (int rep_ = 0; rep_ < NREP(1); ++rep_) { PTRS;
        const bf16* W0T = (const bf16*)(ws + WS_WB) + WB_W0T;
        {   pg::DenseSched S; S.A = XN; S.lda = 1024; S.Bt = W0T; S.K = 1024; S.ord.init(64, 10, G, (int)blockIdx.x);
            pg::EpiProj0 E{QKraw, OM, QB, KB, ROT};
            pg::gemm_phase<pg::EpiProj0, pg::DenseSched>((LAS unsigned char*)lds, 1024, S, E); }
        {   pg::DenseSched S; S.A = W0T + (size_t)2560 * 1024; S.lda = 1024; S.Bt = XN; S.K = 1024; S.ord.init(4, 64, G, (int)blockIdx.x);
            pg::EpiVT0 E{VMT, VBT};
            pg::gemm_phase<pg::EpiVT0, pg::DenseSched>((LAS unsigned char*)lds, 1024, S, E); }
        {   int slot, ns;
            if (fill_slot(640 + 256, G, (int)blockIdx.x, slot, ns)) { LAS float* scr = (LAS float*)lds; bf16* WB = (bf16*)(ws + WS_WB);
                CONV_RUN(slot, 64 + 512, ns, DEC_P1); } }
    }
    SEAM(1);
    if (IN(2)) for (int rep_ = 0; rep_ < NREP(2); ++rep_) { PTRS;
        const bool late_conv = (blockIdx.x & 1u) != 0u;
        if (!late_conv) for (int i = (int)gtid; i < (T_ / 16) * 128; i += (int)NGT) conv_silu_run(i, QKraw, in[3], QM, KM);
        for (int bhq = blockIdx.x; bhq < 32; bhq += G) gates_block(bhq, tid, IFr, in[4], LI, BC, (LAS float*)(lds + 4096));
        {   float* KMEAN = (float*)(sm + SM_KMEAN);
            LAS float* red = (LAS float*)(lds + 8192);
            const int kfirst = G > 64 ? (int)blockIdx.x - 32 : (int)blockIdx.x, kstep = G > 64 ? G - 32 : G;
            for (int pr = kfirst; pr < 128; pr += kstep) { if (pr < 0) break; float acc[8];
#pragma unroll
                for (int e = 0; e < 8; ++e) acc[e] = 0.f;
                const bf16* kp = KB + ((size_t)(pr * 2 + (wave >> 2)) * 256 + (wave & 3) * 64 + (lane >> 4)) * 128 + (lane & 15) * 8;
#pragma unroll
                for (int j = 0; j < 16; ++j) { const uint4 u = *(const uint4*)(kp + (size_t)j * 4 * 128);
                    acc[0] += lo16(u.x); acc[1] += hi16(u.x); acc[2] += lo16(u.y); acc[3] += hi16(u.y); acc[4] += lo16(u.z); acc[5] += hi16(u.z); acc[6] += lo16(u.w); acc[7] += hi16(u.w); }
#pragma unroll
                for (int e = 0; e < 8; ++e) { acc[e] = pair16(acc[e], acc[e]); acc[e] = pair32(acc[e], acc[e]); }
                __syncthreads();
                if (lane < 16) {
#pragma unroll
                    for (int e = 0; e < 8; ++e) red[wave * 128 + lane * 8 + e] = acc[e]; }
                __syncthreads();
                if (tid < 256) { const int hq = tid >> 7, c = tid & 127; float sacc = 0.f;
#pragma unroll
                    for (int q = 0; q < 4; ++q) sacc += red[(hq * 4 + q) * 128 + c];
                    KMEAN[(pr * 2 + hq) * 128 + c] = sacc * (1.f / 256.f); } } }
        if (late_conv) for (int i = (int)gtid; i < (T_ / 16) * 128; i += (int)NGT) conv_silu_run(i, QKraw, in[3], QM, KM);
    }
    SEAM2(2, 4);
    if (IN(4)) for (int rep_ = 0; rep_ < NREP(4); ++rep_) { PTRS;
        const float* KMEAN = (const float*)(sm + SM_KMEAN);
        for (int u = vcu; u < 256; u += G) { const int bh = u >> 3, qb = u & 7;
            at::mlstm_unit(bh, qb, (LAS unsigned char*)lds, QM, KM, VMT, LI, BC, OM, in[5], Y0);
            at::moba_unit(bh, 7 - qb, (LAS unsigned char*)lds, QB, KB, VBT, KMEAN, Y0); }
    }
    SEAM(4);
    if (IN(5)) for (int rep_ = 0; rep_ < NREP(5); ++rep_) { PTRS;
        pg::DenseSched S; S.A = Y0; S.lda = 1024; S.Bt = (const bf16*)(ws + WS_WB) + WB_WO0T; S.K = 1024; S.ord.init(64, 4, G, (int)blockIdx.x);
        pg::EpiOut<false> E{in[0], HB};
        pg::gemm_phase<pg::EpiOut<false>, pg::DenseSched>((LAS unsigned char*)lds, 1024, S, E);
    }
    SEAM(5);
    MOE_BLOCK(0, 6);
            if (IN(10)) for (int rep_ = 0; rep_ < NREP(10); ++rep_) { PTRS;
                const bf16* W1T = (const bf16*)(ws + WS_WB) + WB_W1T;
                {   pg::DenseSched S; S.A = XN; S.lda = 1024; S.Bt = W1T; S.K = 1024; S.ord.init(64, 8, G, (int)blockIdx.x);
                    pg::EpiProj1 E{Q1, KC, VC, KS, KW, ROT};
                    pg::gemm_phase<pg::EpiProj1, pg::DenseSched>((LAS unsigned char*)lds, 1024, S, E); }
            }
            SEAM(10);
            if (IN(11)) for (int rep_ = 0; rep_ < NREP(11); ++rep_) { PTRS;
                const bf16* W1T = (const bf16*)(ws + WS_WB) + WB_W1T;
                const int nvt = G >= 192 ? (G * 2) / 3 : G;
                if ((int)blockIdx.x < nvt || G < 192) {
                    pg::DenseSched S; S.A = W1T + (size_t)2048 * 1024; S.lda = 1024; S.Bt = XN; S.K = 1024; S.ord.init(2, 64, nvt, (int)blockIdx.x);
                    pg::EpiVT1 E{VST, VWT};
                    pg::gemm_phase<pg::EpiVT1, pg::DenseSched>((LAS unsigned char*)lds, 1024, S, E); }
                if ((int)blockIdx.x >= nvt || G < 192) {
                    pg::CmpSched S; S.KC = KC; S.VC = VC; S.WK = (const bf16*)(ws + WS_WB) + WB_CK1T; S.WV = (const bf16*)(ws + WS_WB) + WB_CV1T; S.G = G < 192 ? G : G - nvt; S.c = G < 192 ? (int)blockIdx.x : (int)blockIdx.x - nvt;
                    pg::EpiCmp1 E{(bf16*)PART};
                    pg::gemm_phase<pg::EpiCmp1, pg::CmpSched>((LAS unsigned char*)lds, 1024, S, E, 4096); }
                {   int slot = (int)blockIdx.x, ns = G; bool idle = true;
                    if (G >= 192) { const int b = (int)blockIdx.x;
                        if (b < nvt) { idle = b >= 128; slot = b - 128; } else { idle = b - nvt >= 64; slot = (nvt - 128) + (b - nvt - 64); }
                        ns = G - 192; if (ns <= 0) { idle = true; slot = b; ns = G; } }
                    if (idle) { LAS float* scr = (LAS float*)lds; bf16* WB = (bf16*)(ws + WS_WB);
        {
            LAS float* red = (LAS float*)(lds + 16384);
            for (int o0 = slot; o0 < 256; o0 += ns) { const int o = o0 + 256 * (wave >> 2), kv = o >> 8, n = o & 255, kq = wave & 3;
                const bf16* wrow = (const bf16*)(ws + WS_WB) + (kv ? WB_CV1T : WB_CK1T) + (size_t)n * 4096 + kq * 1024; const float* pe = in[17] + kv * 4096 + kq * 1024;
                float acc = 0.f;
#pragma unroll
                for (int jj = 0; jj < 2; ++jj) { const int j = lane * 8 + jj * 512; const uint4 u = *(const uint4*)(wrow + j); const float4 p0 = *(const float4*)(pe + j), p1 = *(const float4*)(pe + j + 4);
                    acc += p0.x * lo16(u.x) + p0.y * hi16(u.x) + p0.z * lo16(u.y) + p0.w * hi16(u.y) + p1.x * lo16(u.z) + p1.y * hi16(u.z) + p1.z * lo16(u.w) + p1.w * hi16(u.w); }
                acc = wave_sum(acc);
                __syncthreads();
                if (lane == 0) red[wave] = acc;
                __syncthreads();
                if (tid < 2) CB[o0 + 256 * tid] = (red[4 * tid] + red[4 * tid + 1]) + (red[4 * tid + 2] + red[4 * tid + 3]); } }
                        CONV_RUN(F8_BLOCKS + slot, F8_BLOCKS + F11_BLOCKS, ns, DEC_M1); } }
            }
            SEAM(11);
            if (IN(12)) for (int rep_ = 0; rep_ < NREP(12); ++rep_) { PTRS;
                typedef float f4v __attribute__((ext_vector_type(4)));
                LAS float* As2 = (LAS float*)lds;
                LAS float* red = (LAS float*)(lds + 32768);
                for (int item = blockIdx.x; item < 256; item += G) { const int z = item >> 7, rt = item & 127;
                    __syncthreads();
                    for (int idx = tid; idx < 16 * 64; idx += 512) { const int row = idx & 15, k4 = idx >> 4; const int rr = rt * 16 + row;
                        float4 sa = *(const float4*)(CB + z * 256 + 4 * k4);
#pragma unroll
                        for (int ks = 0; ks < 4; ++ks) { const uint2 p = *(const uint2*)((const bf16*)PART + ((size_t)(ks * 2 + z) * 2048 + rr) * 256 + 4 * k4); sa.x += lo16(p.x); sa.y += hi16(p.x); sa.z += lo16(p.y); sa.w += hi16(p.y); }
                        const float vv[4] = {sa.x, sa.y, sa.z, sa.w};
#pragma unroll
                        for (int j = 0; j < 4; ++j) { const float u = 0.7978845608028654f * (vv[j] + 0.044715f * vv[j] * vv[j] * vv[j]); As2[(4 * k4 + j) * 20 + row] = bf2f(f2bf(vv[j] * __builtin_amdgcn_rcpf(1.f + __builtin_amdgcn_exp2f(-2.8853900817779268f * u)))); }        }
                    __syncthreads();
                    {   const int kq = tid >> 7, tx = tid & 31, ty = (tid >> 5) & 3;
                        const float* W2 = (z ? in[21] : in[19]) + (size_t)kq * 64 * 128 + tx * 4;
                        const LAS float* Ap = As2 + kq * 64 * 20 + 4 * ty;
                        f4v acc0 = {0.f, 0.f, 0.f, 0.f}, acc1 = acc0, acc2 = acc0, acc3 = acc0;
#pragma unroll 8
                        for (int kk = 0; kk < 64; ++kk) { const f4v w = *(const f4v*)(W2 + (size_t)kk * 128); const f4v a4 = *(const LAS f4v*)(Ap + kk * 20);
                            acc0 += a4.x * w; acc1 += a4.y * w; acc2 += a4.z * w; acc3 += a4.w * w; }
                        LAS f4v* rp = (LAS f4v*)(red + (kq * 16 + 4 * ty) * 128 + 4 * tx);
                        rp[0] = acc0; rp[32] = acc1; rp[64] = acc2; rp[96] = acc3; }
                    __syncthreads();
                    if (z == 0) { const int row = tid >> 5, c4 = tid & 31; const LAS f4v* rp = (const LAS f4v*)(red + row * 128 + 4 * c4);
                        f4v sv = (rp[0] + rp[512]) + (rp[1024] + rp[1536]);
                        const int r = rt * 16 + row, bgq = r >> 7, nb = r & 127; if (nb == 127) sv = f4v{0.f, 0.f, 0.f, 0.f};
                        *(uint2*)(KCMP + ((size_t)bgq * 128 + nb) * 128 + 4 * c4) = make_uint2(pk2(sv.x, sv.y), pk2(sv.z, sv.w)); }
                    else { const int n = tid >> 2, r4 = tid & 3; float sv[4];
#pragma unroll
                        for (int i = 0; i < 4; ++i) { const LAS float* rp = red + (4 * r4 + i) * 128 + n; sv[i] = (rp[0] + rp[2048]) + (rp[4096] + rp[6144]); }
                        const int r = rt * 16 + 4 * r4, bgq = r >> 7, nb = r & 127; if (nb + 3 == 127) sv[3] = 0.f;
                        *(uint2*)(VCMPT + ((size_t)bgq * 128 + n) * 128 + nb) = make_uint2(pk2(sv[0], sv[1]), pk2(sv[2], sv[3])); }
                }
            }
            SEAM2(12, 14);
            if (IN(14)) for (int rep_ = 0; rep_ < NREP(14); ++rep_) { PTRS;
                for (int u = vcu; u < 256; u += G) { const int bg = u >> 4, p = u & 15;
                    at::nsa_unit(bg, p, (LAS unsigned char*)lds, Q1, ROT, KCMP, VCMPT, KS, VST, KW, VWT, Gt, Y1);
                    at::nsa_unit(bg, 31 - p, (LAS unsigned char*)lds, Q1, ROT, KCMP, VCMPT, KS, VST, KW, VWT, Gt, Y1); }
            }
            if (IN(14)) { PTRS;
                if (G == 256) { const int bg = vcu >> 4, p = vcu & 15;
                    if (p < 8) { const int off = p == 0 ? 0 : p == 1 ? 4 : p == 2 ? 7 : p == 3 ? 10 : p == 4 ? 12 : p == 5 ? 14 : p == 6 ? 16 : 17, cnt = p == 0 ? 4 : p < 3 ? 3 : p < 6 ? 2 : 1;
                        const int first = F8_BLOCKS + F11_BLOCKS + bg * 18 + off; LAS float* scr = (LAS float*)lds; bf16* WB = (bf16*)(ws + WS_WB);
                        CONV_RUN(first, first + cnt, 1, DEC_M1); } }
                else { LAS float* scr = (LAS float*)lds; bf16* WB = (bf16*)(ws + WS_WB); CONV_RUN(F8_BLOCKS + F11_BLOCKS + (int)blockIdx.x, 512 + 256, G, DEC_M1); }
            }
            SEAM(14);
            if (IN(15)) for (int rep_ = 0; rep_ < NREP(15); ++rep_) { PTRS;
                pg::DenseSched S; S.A = Y1; S.lda = 1024; S.Bt = (const bf16*)(ws + WS_WB) + WB_WO1T; S.K = 1024; S.ord.init(64, 4, G, (int)blockIdx.x);
                pg::EpiOut<true> E{YS0, HB};
                pg::gemm_phase<pg::EpiOut<true>, pg::DenseSched>((LAS unsigned char*)lds, 1024, S, E);
            }
            SEAM(15);
    MOE_BLOCK(1, 16);
#undef IN
#undef SEAM
#undef in
}

extern "C" void kernel_launch(void* const* d_in, const int* in_sizes, int n_in, void* d_out, int out_size, void* d_ws, size_t ws_size, hipStream_t stream) {
    (void)in_sizes; (void)out_size; (void)ws_size;
    static int grid = 0;
    if (grid == 0) {
        int dev = 0, cus = 0, per_cu = 0;
        if (hipGetDevice(&dev) != hipSuccess || hipDeviceGetAttribute(&cus, hipDeviceAttributeMultiprocessorCount, dev) != hipSuccess) { grid = -1; return; }
        if (hipFuncSetAttribute((const void*)mk_fwd, hipFuncAttributeMaxDynamicSharedMemorySize, LDS_BYTES) != hipSuccess) { fprintf(stderr, "hipFuncSetAttribute failed\n"); grid = -1; return; }
        if (hipOccupancyMaxActiveBlocksPerMultiprocessor(&per_cu, (const void*)mk_fwd, 512, LDS_BYTES) != hipSuccess || per_cu < 1) fprintf(stderr, "occupancy query: %d\n", per_cu);
        (void)hipGetLastError();
        grid = cus;
    }
    if (grid < 0) return;
    if (hipMemsetAsync((char*)d_ws + WS_CTL, 0, CTL_ZERO_BYTES, stream) != hipSuccess) return;
    Args a{};
    for (int i = 0; i < 32 && i < n_in; ++i) a.in[i] = (const float*)d_in[i];
    a.out = (float*)d_out; a.ws = (unsigned char*)d_ws; a.ph_lo = 0; a.ph_hi = N_PHASES;
    hipLaunchKernelGGL(mk_fwd, dim3(grid), dim3(512), LDS_BYTES, stream, a);
}
```

```cpp
#include <hip/hip_runtime.h>
#include <stdint.h>
#include <math.h>
#include <stdio.h>

#define T_ 16384
#define S_ 2048
#define D_ 1024
#define NEGINF (-1e30f)

typedef unsigned short bf16;
__device__ __forceinline__ float bf2f(bf16 v) { return __uint_as_float(((unsigned)v) << 16); }
__device__ __forceinline__ bf16 f2bf(float f) { unsigned u = __float_as_uint(f); return (bf16)((u + 0x7fffu + ((u >> 16) & 1u)) >> 16); }
__device__ __forceinline__ unsigned pk2(float lo, float hi) { unsigned r; asm("v_cvt_pk_bf16_f32 %0, %1, %2" : "=v"(r) : "v"(lo), "v"(hi)); return r; }
__device__ __forceinline__ float lo16(unsigned u) { return __uint_as_float(u << 16); }
__device__ __forceinline__ float hi16(unsigned u) { return __uint_as_float(u & 0xffff0000u); }
template <int CTRL> __device__ __forceinline__ float dpp_mov(float x) { return __builtin_bit_cast(float, __builtin_amdgcn_update_dpp(0, __builtin_bit_cast(int, x), CTRL, 0xF, 0xF, true)); }
__device__ __forceinline__ float row16_sum(float v) { v += dpp_mov<0x128>(v); v += dpp_mov<0x124>(v); v += dpp_mov<0x122>(v); v += dpp_mov<0x121>(v); return v; }
__device__ __forceinline__ float pair32(float a, float b) { const auto r = __builtin_amdgcn_permlane32_swap(__float_as_uint(a), __float_as_uint(b), false, false); return __uint_as_float(r[0]) + __uint_as_float(r[1]); }
__device__ __forceinline__ float pair16(float a, float b) { const auto r = __builtin_amdgcn_permlane16_swap(__float_as_uint(a), __float_as_uint(b), false, false); return __uint_as_float(r[0]) + __uint_as_float(r[1]); }
__device__ __forceinline__ float wave_sum(float v) { v = row16_sum(v); v = pair16(v, v); return pair32(v, v); }
__device__ __forceinline__ float wave_max(float v) {
#pragma unroll
    for (int o = 32; o > 0; o >>= 1) v = fmaxf(v, __shfl_xor(v, o));
    return v; }
__device__ __forceinline__ float sigmoidf_(float x) { return __builtin_amdgcn_rcpf(1.f + __expf(-x)); }

constexpr size_t MiB = 1ull << 20;
constexpr size_t WS_CTL = 0;
constexpr size_t WS_WB = 256 * 1024;
constexpr size_t WS_R0 = 69 * MiB;
constexpr size_t WS_R1 = 101 * MiB;
constexpr size_t WS_R2 = 133 * MiB;
constexpr size_t WS_R3 = 165 * MiB;
constexpr size_t WS_R4 = 197 * MiB;
constexpr size_t WS_R5 = 229 * MiB;
constexpr size_t WS_SM = 245 * MiB;
constexpr size_t SM_IF = 0;
constexpr size_t SM_LI = SM_IF + 512 * 1024;
constexpr size_t SM_BC = SM_LI + 256 * 1024;
constexpr size_t SM_KMEAN = SM_BC + 256 * 1024;
constexpr size_t SM_LIST = SM_KMEAN + 128 * 1024;
constexpr size_t SM_LISTW = SM_LIST + 1 * MiB;
constexpr size_t SM_SELM = SM_LISTW + 1 * MiB;
constexpr size_t SM_G = SM_SELM + 128 * 1024;
constexpr size_t SM_HC = SM_G + 1536 * 1024;
constexpr size_t SM_KCMP = SM_HC + 2 * MiB;
constexpr size_t SM_VCMPT = SM_KCMP + 512 * 1024;
constexpr size_t SM_ROT = SM_VCMPT + 512 * 1024;
constexpr size_t SM_CB = SM_ROT + 1 * MiB;
constexpr size_t SM_LISTR = SM_CB + 4096;
constexpr size_t SM_END = SM_LISTR + 1 * MiB;
static_assert(SM_END <= 11 * MiB, "small region");
static_assert(WS_R3 - WS_R2 == (size_t)T_ * 1024 * 2, "YS slot 1 directly follows YS slot 0");
constexpr int CW_CNT = 1024;
constexpr int CW_BAR = 4096;
constexpr int CW_DONE = 8192;
constexpr size_t CTL_ZERO_BYTES = 128 * 1024;

constexpr int LDS_BYTES = 147456;
constexpr int LDSCTL_OFF = 143360;
constexpr int MISC_OFF = LDSCTL_OFF + 320;

#define LAS __attribute__((address_space(3)))
#define XB_TMO      128
#define XB_XCNT(j)  (256  + 64 * (j))
#define XB_XSUB(j)  (1280 + 64 * (j))
#define XB_XGEN(j)  (2304 + 64 * (j))
#define XB_TOP      3328
#define XB_TOPGEN   3392
#define XCD_BAR_WORDS 3456
#define XB_SPIN_CAP (1u << 22)
__device__ __forceinline__ unsigned xb_ld(unsigned* p)              { return __hip_atomic_load(p, __ATOMIC_RELAXED, __HIP_MEMORY_SCOPE_AGENT); }
__device__ __forceinline__ unsigned xb_add(unsigned* p, unsigned v) { return __hip_atomic_fetch_add(p, v, __ATOMIC_RELAXED, __HIP_MEMORY_SCOPE_AGENT); }
__device__ __forceinline__ unsigned xb_xcc_id() { return (unsigned)__builtin_amdgcn_s_getreg((3 << 11) | 20) & 0xFu; }
#define XB_SPIN(cond, bar) do { unsigned _sp = 0; while (cond) { __builtin_amdgcn_s_sleep(1); \
    if ((++_sp & 255u) == 0u) { if (xb_ld(&(bar)[XB_TMO])) break; if (_sp > XB_SPIN_CAP) { atomicAdd(&(bar)[XB_TMO], 1u); break; } } } } while (0)
struct XcdBarrier { unsigned* bar; unsigned x; volatile LAS unsigned* st; };
__device__ __forceinline__ XcdBarrier xcd_barrier_post(unsigned* bar, volatile LAS unsigned* st) {
    XcdBarrier b; b.bar = bar; b.x = xb_xcc_id(); b.st = st;
    if (threadIdx.x == 0) (void)xb_add(&bar[XB_XCNT(b.x)], 1u);
    return b;
}
__device__ __forceinline__ void xcd_barrier_complete(unsigned* bar, unsigned x, unsigned& nloc, unsigned& nx) {
    const unsigned G = gridDim.x * gridDim.y * gridDim.z;
    unsigned sum, cnt, mine, sp = 0u;
    for (;;) {
        sum = 0u; cnt = 0u; mine = 0u;
#pragma unroll
        for (unsigned j = 0; j < 16; ++j) { const unsigned c = xb_ld(&bar[XB_XCNT(j)]); sum += c; cnt += (c > 0u) ? 1u : 0u; mine = (j == x) ? c : mine; }
        if (sum == G) break;
        __builtin_amdgcn_s_sleep(1);
        if ((++sp & 255u) == 0u) { if (xb_ld(&bar[XB_TMO])) break; if (sp > XB_SPIN_CAP) { atomicAdd(&bar[XB_TMO], 1u); break; } }
    }
    nloc = mine > 0u ? mine : 1u; nx = cnt > 0u ? cnt : 1u;
}
__device__ __forceinline__ void xcd_barrier(const XcdBarrier& b) {
    asm volatile("s_waitcnt vmcnt(0)" ::: "memory");
    __syncthreads();
    if (threadIdx.x == 0) {
        unsigned* bar = b.bar;
        __builtin_amdgcn_s_waitcnt(0);
        unsigned nloc = b.st[0], nx = b.st[1];
        if (nloc == 0u) { xcd_barrier_complete(bar, b.x, nloc, nx); b.st[0] = nloc; b.st[1] = nx; }
        const unsigned gen = b.st[2]; b.st[2] = gen + 1u;
        unsigned old;
        {   unsigned* ap_ = &bar[XB_XSUB(b.x)]; const unsigned one_ = 1u;
            asm volatile("global_atomic_add %0, %1, %2, off sc0\n\tbuffer_inv sc1\n\ts_waitcnt vmcnt(1)" : "=&v"(old) : "v"(ap_), "v"(one_) : "memory"); }
        if (old + 1u == (gen + 1u) * nloc) {
            __builtin_amdgcn_fence(__ATOMIC_RELEASE, "agent");
            asm volatile("s_waitcnt vmcnt(0)" ::: "memory");
#pragma unroll
            for (unsigned j = 0; j < 16; ++j) (void)xb_add(&bar[XB_XGEN(j)], 1u);
        }
        XB_SPIN(xb_ld(&bar[XB_XGEN(b.x)]) < (gen + 1u) * nx, bar);
        asm volatile("s_waitcnt vmcnt(0)" ::: "memory");
    }
    __syncthreads();
}

template <class G, bool DUAL>
__device__ __forceinline__ void gemm_tile_naive(const G& g, int z, int tile_m, int tile_n, bool active, int tid, float* ldsh) {
    float (*As)[68] = (float (*)[68])ldsh;
    float (*Ws)[16][68] = (float (*)[16][68])(ldsh + 16 * 68);
    const int M = active ? g.M(z) : 0;
    const int tx = tid & 15, ty = tid >> 4;
    float acc[4][4], acc2[4][4];
#pragma unroll
    for (int i = 0; i < 4; ++i)
#pragma unroll
        for (int j = 0; j < 4; ++j) { acc[i][j] = 0.f; acc2[i][j] = 0.f; }
    const int ar = tid >> 2, ak = (tid & 3) * 4;
    const int wk = tid >> 4, wn = (tid & 15) * 4;
    const float* Wp = g.W(z);
    const float* Wp2 = DUAL ? g.W2(z) : nullptr;
    const bool wok = active && (tile_n + wn) < g.N;
    for (int k0 = 0; k0 < g.K; k0 += 16) {
        float a4[4] = {0.f, 0.f, 0.f, 0.f};
        if (tile_m + ar < M) g.aload(z, tile_m + ar, k0 + ak, a4);
        float4 w4 = make_float4(0.f, 0.f, 0.f, 0.f), w42 = w4;
        if (wok) { w4 = *(const float4*)(Wp + (size_t)(k0 + wk) * g.ldw + tile_n + wn); if (DUAL) w42 = *(const float4*)(Wp2 + (size_t)(k0 + wk) * g.ldw + tile_n + wn); }
        __syncthreads();
#pragma unroll
        for (int i = 0; i < 4; ++i) As[ak + i][ar] = a4[i];
        Ws[0][wk][wn + 0] = w4.x; Ws[0][wk][wn + 1] = w4.y; Ws[0][wk][wn + 2] = w4.z; Ws[0][wk][wn + 3] = w4.w;
        if (DUAL) { Ws[1][wk][wn + 0] = w42.x; Ws[1][wk][wn + 1] = w42.y; Ws[1][wk][wn + 2] = w42.z; Ws[1][wk][wn + 3] = w42.w; }
        __syncthreads();
#pragma unroll
        for (int kk = 0; kk < 16; ++kk) {
            float a[4], w[4], w2[4];
#pragma unroll
            for (int i = 0; i < 4; ++i) a[i] = As[kk][ty * 4 + i];
#pragma unroll
            for (int j = 0; j < 4; ++j) { w[j] = Ws[0][kk][tx * 4 + j]; w2[j] = DUAL ? Ws[1][kk][tx * 4 + j] : 0.f; }
#pragma unroll
            for (int i = 0; i < 4; ++i)
#pragma unroll
                for (int j = 0; j < 4; ++j) { acc[i][j] += a[i] * w[j]; if (DUAL) acc2[i][j] += a[i] * w2[j]; }
        }
    }
#pragma unroll
    for (int i = 0; i < 4; ++i)
#pragma unroll
        for (int j = 0; j < 4; ++j) { const int m = tile_m + ty * 4 + i, n = tile_n + tx * 4 + j; if (m < M && n < g.N) g.store(z, m, n, acc[i][j], acc2[i][j]); }
}
template <class G, bool DUAL>
__device__ __forceinline__ void gemm_phase_naive(const G& g, int mt, int nt, int nz, int tid512, float* lds) {
    const int half = tid512 >> 8, tid = tid512 & 255; float* ldsh = lds + half * (3 * 16 * 68);
    const int nvb = mt * nt * nz, stride = 2 * (int)gridDim.x;
    for (int v0 = 2 * (int)blockIdx.x; v0 < nvb; v0 += stride) {
        const int vb = v0 + half; const bool active = vb < nvb; const int vv = active ? vb : 0;
        const int x = vv % mt, y = (vv / mt) % nt, z = vv / (mt * nt);
        gemm_tile_naive<G, DUAL>(g, z, x * 64, y * 64, active, tid, ldsh);
    }
}
template <class G, bool DUAL>
__device__ __forceinline__ void gemm_phase_moe_naive(const G& g, const int* cnt, int nt, int tid512, float* lds) {
    const int half = tid512 >> 8, tid = tid512 & 255; float* ldsh = lds + half * (3 * 16 * 68);
    int pre[17]; pre[0] = 0;
#pragma unroll
    for (int e = 0; e < 16; ++e) pre[e + 1] = pre[e] + (cnt[e] + 63) / 64;
    const int nvb = pre[16] * nt, stride = 2 * (int)gridDim.x;
    for (int v0 = 2 * (int)blockIdx.x; v0 < nvb; v0 += stride) {
        const int vb = v0 + half; const bool active = vb < nvb; const int vv = active ? vb : 0;
        const int mtile = vv / nt, y = vv % nt; int e = 0;
#pragma unroll
        for (int q = 1; q < 16; ++q) e += (mtile >= pre[q]) ? 1 : 0;
        int pe = 0;
#pragma unroll
        for (int q = 0; q < 16; ++q) pe = (q == e) ? pre[q] : pe;
        gemm_tile_naive<G, DUAL>(g, e, (mtile - pe) * 64, y * 64, active, tid, ldsh);
    }
}

struct GProj0 {
    const bf16* xn; const float* w; bf16 *qkraw, *vmt, *om, *qb, *kb, *vbt; const float* abias; int N, K, ldw;
    __device__ int M(int) const { return T_; }
    __device__ const bf16* arow(int, int m) const { return xn + (size_t)m * D_; }
    __device__ const float* W(int) const { return w; }
    __device__ const float* W2(int) const { return w; }
    __device__ void store(int, int m, int n, float v, float) const {
        const int b = m >> 11, s = m & 2047; const bf16 o = f2bf(v);
        if (n < 1024) qkraw[(size_t)m * 1024 + n] = o;
        else if (n < 1536) { const int c = n - 1024; vmt[((size_t)(b * 4 + (c >> 7)) * 128 + (c & 127)) * 2048 + s] = o; }
        else if (n < 2048) om[(size_t)m * 512 + (n - 1536)] = o;
        else if (n < 2056) {}
        else if (n < 2568) { const int c = n - 2056; qb[((size_t)(b * 4 + (c >> 7)) * 2048 + s) * 128 + (c & 127)] = o; }
        else if (n < 3080) { const int c = n - 2568; kb[((size_t)(b * 4 + (c >> 7)) * 2048 + s) * 128 + (c & 127)] = o; }
        else { const int c = n - 3080; vbt[((size_t)(b * 4 + (c >> 7)) * 128 + (c & 127)) * 2048 + s] = o; }
    }
};
struct GProj1 {
    const bf16* xn; const float* w; bf16 *q1, *kc, *vc, *ks, *vst, *kw, *vwt; const float* abias; int N, K, ldw;
    __device__ int M(int) const { return T_; }
    __device__ const bf16* arow(int, int m) const { return xn + (size_t)m * D_; }
    __device__ const float* W(int) const { return w; }
    __device__ const float* W2(int) const { return w; }
    __device__ void store(int, int m, int n, float v, float) const {
        const int b = m >> 11, s = m & 2047; const bf16 o = f2bf(v);
        if (n < 1024) q1[((size_t)(b * 8 + (n >> 7)) * 2048 + s) * 128 + (n & 127)] = o;
        else if (n < 2560) { const int c = n - 1024, which = c >> 8, cc = c & 255, gI = cc >> 7, d = cc & 127;
            const size_t hm = ((size_t)(b * 2 + gI) * 2048 + s) * 128 + d, tm = ((size_t)(b * 2 + gI) * 128 + d) * 2048 + s;
            if (which == 0) kc[hm] = o; else if (which == 1) vc[hm] = o; else if (which == 2) ks[hm] = o; else if (which == 3) vst[tm] = o; else if (which == 4) kw[hm] = o; else vwt[tm] = o; }
    }
};
struct GOut {
    const bf16* y; const float* w; const float* hin; float* hout; const float* abias; int N, K, ldw;
    __device__ int M(int) const { return T_; }
    __device__ const bf16* arow(int, int m) const { return y + (size_t)m * D_; }
    __device__ const float* W(int) const { return w; }
    __device__ const float* W2(int) const { return w; }
    __device__ void store(int, int m, int n, float v, float) const { const size_t i = (size_t)m * D_ + n; hout[i] = hin[i] + v; }
};
__device__ __forceinline__ int moe_row_base(const int* cnt, int z) { int acc = 0;
#pragma unroll
    for (int e = 0; e < 16; ++e) acc += (e < z) ? ((cnt[e] + 255) & ~255) : 0;
    return acc; }
struct GMoe1 {
    const bf16* xn; const float* w1; const float* w3; const int* cnt; const int* list; bf16* H; const float* abias; int N, K, ldw;
    __device__ int M(int z) const { return cnt[z]; }
    __device__ const bf16* arow(int z, int m) const { return xn + (size_t)(list[z * T_ + m] >> 1) * D_; }
    __device__ const float* W(int z) const { return w1 + (size_t)z * 1024 * 256; }
    __device__ const float* W2(int z) const { return w3 + (size_t)z * 1024 * 256; }
    __device__ void store(int z, int m, int n, float a, float b) const { H[(size_t)(moe_row_base(cnt, z) + m) * 256 + n] = f2bf(a * sigmoidf_(a) * b); }
};
struct GMoe2 {
    const bf16* H; const float* w2; const int* cnt; const int* list; const float* listw; bf16* ys0; bf16* ys1; const float* abias; int N, K, ldw;
    __device__ int M(int z) const { return cnt[z]; }
    __device__ const bf16* arow(int z, int m) const { return H + (size_t)(moe_row_base(cnt, z) + m) * 256; }
    __device__ const float* W(int z) const { return w2 + (size_t)z * 256 * 1024; }
    __device__ const float* W2(int z) const { return w2; }
    __device__ void store(int z, int m, int n, float v, float) const { const int e = list[z * T_ + m]; const float w = listw[z * T_ + m];
        bf16* ys = (e & 1) ? ys1 : ys0; ys[(size_t)(e >> 1) * D_ + n] = f2bf(w * v); }
};
struct GCmp1 {
    const bf16* kc; const bf16* vc; const float* wk1; const float* wv1; const float* pe; bf16* hc; const float* abias; int N, K, ldw;
    __device__ int M(int) const { return 2048; }
    __device__ const bf16* arow(int z, int r) const { const int bg = r >> 7, nb = r & 127; if (nb == 127) return nullptr; return (z ? vc : kc) + ((size_t)bg * 2048 + 16 * nb) * 128; }
    __device__ const float* W(int z) const { return z ? wv1 : wk1; }
    __device__ const float* W2(int z) const { return wk1; }
    __device__ void store(int z, int r, int n, float v, float) const { const float u = 0.7978845608028654f * (v + 0.044715f * v * v * v); hc[((size_t)z * 2048 + r) * 256 + n] = f2bf(0.5f * v * (1.f + tanhf(u))); }
};
struct GCmp2 {
    const float* part; const float* cb; const float* wk2; const float* wv2; bf16* kcmp; bf16* vcmpt; int N, K, ldw;
    __device__ int M(int) const { return 2048; }
    __device__ void aload(int z, int r, int k, float (&a4)[4]) const {
        float4 sacc = *(const float4*)(cb + z * 256 + k);
#pragma unroll
        for (int ks = 0; ks < 4; ++ks) { const float4 p = *(const float4*)(part + ((size_t)(ks * 2 + z) * 2048 + r) * 256 + k); sacc.x += p.x; sacc.y += p.y; sacc.z += p.z; sacc.w += p.w; }
        const float v[4] = {sacc.x, sacc.y, sacc.z, sacc.w};
#pragma unroll
        for (int i = 0; i < 4; ++i) { const float u = 0.7978845608028654f * (v[i] + 0.044715f * v[i] * v[i] * v[i]); a4[i] = bf2f(f2bf(0.5f * v[i] * (1.f + tanhf(u)))); }
    }
    __device__ const float* W(int z) const { return z ? wv2 : wk2; }
    __device__ const float* W2(int z) const { return wk2; }
    __device__ void store(int z, int r, int n, float v, float) const { const int bg = r >> 7, nb = r & 127; const float vv = (nb == 127) ? 0.f : v;
        if (z == 0) kcmp[((size_t)bg * 128 + nb) * 128 + n] = f2bf(vv); else vcmpt[((size_t)bg * 128 + n) * 128 + nb] = f2bf(vv); }
};

template <int NAUX, int NP>
__device__ __forceinline__ void stage_aux(LAS float* Wl, const float* W0, int ld0, int n0, const float* W1, int ld1, int tid) {
    typedef float f4v __attribute__((ext_vector_type(4)));
    f4v buf[2][NAUX / 4];
#pragma unroll
    for (int kk = 0; kk < 2; ++kk) { const int k = tid + 512 * kk;
#pragma unroll
        for (int c4 = 0; c4 < NAUX / 4; ++c4) buf[kk][c4] = (4 * c4 < n0) ? *(const f4v*)(W0 + (size_t)k * ld0 + 4 * c4) : *(const f4v*)(W1 + (size_t)k * ld1 + (4 * c4 - n0)); }
#pragma unroll
    for (int kk = 0; kk < 2; ++kk) { const int k = tid + 512 * kk; const int slot = (((k >> 8) * 4 + (k & 3)) * 64 + ((k & 255) >> 2));
#pragma unroll
        for (int c4 = 0; c4 < NAUX / 4; ++c4) *(LAS f4v*)(Wl + slot * NP + 4 * c4) = buf[kk][c4]; }
}
template <int NAUX, int NP, class Emit>
__device__ __forceinline__ void aux_dots(const float (&v)[16], const LAS float* Wl, int lane, const Emit& emit, int c4a = 0, int c4b = NAUX / 4) {
    typedef float f4v __attribute__((ext_vector_type(4)));
#pragma nounroll
    for (int c4 = c4a; c4 < c4b; ++c4) {
        f4v a = {0.f, 0.f, 0.f, 0.f};
        const LAS float* wr = Wl + lane * NP + 4 * c4;
#pragma unroll
        for (int ji = 0; ji < 16; ++ji) { const f4v w = *(const LAS f4v*)(wr + ji * 64 * NP); a += v[ji] * w; }
        const float k0 = pair32(a[0], a[2]), k1 = pair32(a[1], a[3]);
        const float r = row16_sum(pair16(k0, k1));
        emit(4 * c4 + 2 * (lane >> 5) + ((lane >> 4) & 1), r);
    }
}
template <int NAUX, int NP, class Emit>
__device__ __forceinline__ void aux_dots2(const float (&va)[16], const float (&vb)[16], const LAS float* Wl, int lane, const Emit& emit, int c4a = 0, int c4b = NAUX / 4) {
    typedef float f4v __attribute__((ext_vector_type(4)));
#pragma nounroll
    for (int c4 = c4a; c4 < c4b; ++c4) {
        f4v a = {0.f, 0.f, 0.f, 0.f}, b = {0.f, 0.f, 0.f, 0.f};
        const LAS float* wr = Wl + lane * NP + 4 * c4;
#pragma unroll
        for (int ji = 0; ji < 16; ++ji) { const f4v w = *(const LAS f4v*)(wr + ji * 64 * NP); a += va[ji] * w; b += vb[ji] * w; }
        const float k0 = pair32(a[0], a[2]), k1 = pair32(a[1], a[3]), j0 = pair32(b[0], b[2]), j1 = pair32(b[1], b[3]);
        const float r = row16_sum(pair16(k0, k1)), q = row16_sum(pair16(j0, j1));
        const int col = 4 * c4 + 2 * (lane >> 5) + ((lane >> 4) & 1);
        emit(0, col, r); emit(1, col, q);
    }
}
struct RowNormArgs { const float* base; const bf16* baseh; const bf16* add0; const bf16* add1; bf16* hout; const float* gain; bf16* xn; float* fout; int auxAct; float* auxOut; float4 g[4]; };
struct RowRaw { float4 b[4]; uint2 a0[4]; uint2 a1[4]; };
template <class TB>
__device__ __forceinline__ void row_load(RowRaw& rr, const TB* base, const bf16* add0, const bf16* add1, int row, int lane) {
    const size_t ro = (size_t)row * D_;
    typedef float f4v __attribute__((ext_vector_type(4))); typedef unsigned u2v __attribute__((ext_vector_type(2)));
#pragma unroll
    for (int j = 0; j < 4; ++j) {
        if (sizeof(TB) == 4) { const f4v t = __builtin_nontemporal_load((const f4v*)((const float*)base + ro + j * 256 + lane * 4)); rr.b[j] = make_float4(t[0], t[1], t[2], t[3]); }
        else { const u2v t = __builtin_nontemporal_load((const u2v*)((const bf16*)base + ro + j * 256 + lane * 4)); rr.b[j] = make_float4(lo16(t[0]), hi16(t[0]), lo16(t[1]), hi16(t[1])); } }
    if (add0) {
#pragma unroll
        for (int j = 0; j < 4; ++j) { const u2v t0 = __builtin_nontemporal_load((const u2v*)(add0 + ro + j * 256 + lane * 4)); u2v t1 = {0u, 0u}; if (add1) t1 = __builtin_nontemporal_load((const u2v*)(add1 + ro + j * 256 + lane * 4));
            rr.a0[j] = make_uint2(t0[0], t0[1]); rr.a1[j] = make_uint2(t1[0], t1[1]); } }
}
__device__ __forceinline__ void rownorm_prep(const RowNormArgs& a, int row, int lane, const RowRaw& rr, float (&v)[16]) {
    const size_t ro = (size_t)row * D_;
#pragma unroll
    for (int j = 0; j < 4; ++j) { const float4 x = rr.b[j]; v[4 * j] = x.x; v[4 * j + 1] = x.y; v[4 * j + 2] = x.z; v[4 * j + 3] = x.w; }
    if (a.add0) {
#pragma unroll
        for (int j = 0; j < 4; ++j) { const uint2 u = rr.a0[j], w = rr.a1[j];
            v[4 * j] += lo16(u.x) + lo16(w.x); v[4 * j + 1] += hi16(u.x) + hi16(w.x); v[4 * j + 2] += lo16(u.y) + lo16(w.y); v[4 * j + 3] += hi16(u.y) + hi16(w.y); } }
    if (a.hout) {
#pragma unroll
        for (int j = 0; j < 4; ++j) { uint2 o; o.x = pk2(v[4 * j], v[4 * j + 1]); o.y = pk2(v[4 * j + 2], v[4 * j + 3]); *(uint2*)(a.hout + ro + j * 256 + lane * 4) = o; } }
    float ss = 0.f;
#pragma unroll
    for (int i = 0; i < 16; ++i) ss += v[i] * v[i];
    ss = wave_sum(ss);
    const float rstd = rsqrtf(ss * (1.f / D_) + 1e-6f);
#pragma unroll
    for (int j = 0; j < 4; ++j) { const float4 gg = a.g[j]; v[4 * j] *= rstd * gg.x; v[4 * j + 1] *= rstd * gg.y; v[4 * j + 2] *= rstd * gg.z; v[4 * j + 3] *= rstd * gg.w; }
    if (a.xn) {
#pragma unroll
        for (int j = 0; j < 4; ++j) { uint2 o; o.x = (unsigned)f2bf(v[4 * j]) | ((unsigned)f2bf(v[4 * j + 1]) << 16); o.y = (unsigned)f2bf(v[4 * j + 2]) | ((unsigned)f2bf(v[4 * j + 3]) << 16);
            *(uint2*)(a.xn + ro + j * 256 + lane * 4) = o; } }
    if (a.fout) { typedef float f4v __attribute__((ext_vector_type(4)));
#pragma unroll
        for (int j = 0; j < 4; ++j) { const f4v t = {v[4 * j], v[4 * j + 1], v[4 * j + 2], v[4 * j + 3]}; __builtin_nontemporal_store(t, (f4v*)(a.fout + ro + j * 256 + lane * 4)); } }
}
template <int NAUX, int NP>
__device__ __forceinline__ void rownorm_row(const RowNormArgs& a, int row, int lane, const LAS float* Wl, const RowRaw& rr) {
    float v[16]; rownorm_prep(a, row, lane, rr, v);
    if (NAUX > 0) {
        float* out = a.auxOut + (size_t)row * NAUX; const int act = a.auxAct;
        aux_dots<(NAUX > 0 ? NAUX : 4), NP>(v, Wl, lane, [=](int col, float r) { if ((lane & 15) == 0) out[col] = act ? sigmoidf_(r) : r; });
    }
}
template <int NAUX, int NP>
__device__ __forceinline__ void rownorm_row2(const RowNormArgs& a, int row0, int row1, int lane, const LAS float* Wl, const RowRaw& ra, const RowRaw& rb) {
    float va[16], vb[16]; rownorm_prep(a, row0, lane, ra, va); rownorm_prep(a, row1, lane, rb, vb);
    if (NAUX > 0) {
        float* out0 = a.auxOut + (size_t)row0 * NAUX; float* out1 = a.auxOut + (size_t)row1 * NAUX; const int act = a.auxAct;
        aux_dots2<(NAUX > 0 ? NAUX : 4), NP>(va, vb, Wl, lane, [=](int which, int col, float r) { if ((lane & 15) == 0) (which ? out1 : out0)[col] = act ? sigmoidf_(r) : r; });
    }
}

struct RouteArgs { const bf16* h; const float* gain; const float* bg; const float* be; int* cnt; int* list; float* listw; float4 g[4]; };
__device__ __forceinline__ float route_prep(const RouteArgs& a, int lane, const RowRaw& rr, float (&v)[16]) {
#pragma unroll
    for (int j = 0; j < 4; ++j) { const float4 x = rr.b[j]; v[4 * j] = x.x; v[4 * j + 1] = x.y; v[4 * j + 2] = x.z; v[4 * j + 3] = x.w; }
    float ss = 0.f;
#pragma unroll
    for (int i = 0; i < 16; ++i) ss += v[i] * v[i];
    ss = wave_sum(ss);
    const float rstd = rsqrtf(ss * (1.f / D_) + 1e-6f);
#pragma unroll
    for (int j = 0; j < 4; ++j) { const float4 gg = a.g[j]; v[4 * j] *= rstd * gg.x; v[4 * j + 1] *= rstd * gg.y; v[4 * j + 2] *= rstd * gg.z; v[4 * j + 3] *= rstd * gg.w; }
    return rstd;
}
__device__ __forceinline__ void route_finish(int row, float rstd, int lane, volatile float* L, volatile LAS int* rec, LAS int* lcnt, bool active_lane = true, bool use_active = false) {
    if (use_active ? active_lane : lane == 0) {
        float lg[4];
#pragma unroll
        for (int j = 0; j < 4; ++j) lg[j] = L[j];
        int gt = 0; float gm = lg[0];
#pragma unroll
        for (int j = 1; j < 4; ++j) if (lg[j] > gm) { gm = lg[j]; gt = j; }
        float den = 0.f;
#pragma unroll
        for (int j = 0; j < 4; ++j) den += __expf(lg[j] - gm);
        const float gw = __builtin_amdgcn_rcpf(den);
        float le[4];
#pragma unroll
        for (int j = 0; j < 4; ++j) le[j] = L[4 + gt * 4 + j];
        int i0 = 0; float v0 = le[0];
#pragma unroll
        for (int j = 1; j < 4; ++j) if (le[j] > v0) { v0 = le[j]; i0 = j; }
        int i1 = -1; float v1 = 0.f;
#pragma unroll
        for (int j = 0; j < 4; ++j) { if (j == i0) continue; const float x = le[j]; if (i1 < 0 || x > v1) { v1 = x; i1 = j; } }
        const float e = __expf(v1 - v0), w0 = gw * __builtin_amdgcn_rcpf(1.f + e), w1 = w0 * e;
        const int e0 = gt * 4 + i0, e1 = gt * 4 + i1;
        const int p0 = atomicAdd((int*)(lcnt + e0), 1), p1 = atomicAdd((int*)(lcnt + e1), 1);
        rec[0] = row; rec[1] = e0; rec[2] = e1; rec[3] = p0; rec[4] = p1; ((volatile LAS float*)rec)[5] = w0; ((volatile LAS float*)rec)[6] = w1; ((volatile LAS float*)rec)[7] = rstd;
    }
}
__device__ __forceinline__ void route_row(const RouteArgs& a, int row, int lane, volatile float* L, const LAS float* Wl, volatile LAS int* rec, LAS int* lcnt, const RowRaw& rr) {
    float v[16]; const float rstd = route_prep(a, lane, rr, v);
    {   const float* bg = a.bg; const float* be = a.be;
        aux_dots<20, 20>(v, Wl, lane, [=](int col, float r) { if ((lane & 15) == 0) L[col] = r + (col < 4 ? bg[col & 3] : be[(col - 4) & 15]); }); }
    route_finish(row, rstd, lane, L, rec, lcnt);
}
__device__ __forceinline__ void route_row2(const RouteArgs& a, int row0, int row1, int lane, volatile float* L, const LAS float* Wl, volatile LAS int* rec0, volatile LAS int* rec1, LAS int* lcnt, const RowRaw& ra, const RowRaw& rb) {
    float va[16], vb[16]; const float rs0 = route_prep(a, lane, ra, va), rs1 = route_prep(a, lane, rb, vb);
    {   const float* bg = a.bg; const float* be = a.be;
        aux_dots2<20, 20>(va, vb, Wl, lane, [=](int which, int col, float r) { if ((lane & 15) == 0) L[32 * which + col] = r + bg[col & 3]; }, 0, 1);
        int g0 = 0, g1 = 0; { float m0 = L[0], m1 = L[32];
#pragma unroll
            for (int j = 1; j < 4; ++j) { const float x0 = L[j], x1 = L[32 + j]; if (x0 > m0) { m0 = x0; g0 = j; } if (x1 > m1) { m1 = x1; g1 = j; } } }
        g0 = __builtin_amdgcn_readfirstlane(g0); g1 = __builtin_amdgcn_readfirstlane(g1);
        if (g0 == g1) aux_dots2<20, 20>(va, vb, Wl, lane, [=](int which, int col, float r) { if ((lane & 15) == 0) L[32 * which + col] = r + be[(col - 4) & 15]; }, 1 + g0, 2 + g0);
        else { aux_dots<20, 20>(va, Wl, lane, [=](int col, float r) { if ((lane & 15) == 0) L[col] = r + be[(col - 4) & 15]; }, 1 + g0, 2 + g0);
               aux_dots<20, 20>(vb, Wl, lane, [=](int col, float r) { if ((lane & 15) == 0) L[32 + col] = r + be[(col - 4) & 15]; }, 1 + g1, 2 + g1); } }
    route_finish(lane ? row1 : row0, lane ? rs1 : rs0, lane, L + 32 * (lane & 1), lane ? rec1 : rec0, lcnt, lane < 2, true);
}

__device__ __forceinline__ void conv_silu_elem(size_t idx, const bf16* qkraw, const float* cw, bf16* qm, bf16* km) {
    const int m = (int)(idx >> 10), c = (int)(idx & 1023), b = m >> 11, s = m & 2047;
    float acc = 0.f;
#pragma unroll
    for (int j = 0; j < 4; ++j) { const int ss = s - 3 + j; if (ss >= 0) acc += cw[j * 1024 + c] * bf2f(qkraw[(size_t)(m - 3 + j) * 1024 + c]); }
    const float y = acc * sigmoidf_(acc);
    const int cc = c & 511, hh = cc >> 7, d = cc & 127;
    (c < 512 ? qm : km)[((size_t)(b * 4 + hh) * 2048 + s) * 128 + d] = f2bf(y);
}
__device__ __forceinline__ void conv_silu_vec(size_t idx, const bf16* qkraw, const float* cw, bf16* qm, bf16* km) {
    const int m = (int)(idx >> 7), c0 = (int)(idx & 127) * 8, b = m >> 11, s = m & 2047;
    float acc[8];
#pragma unroll
    for (int e = 0; e < 8; ++e) acc[e] = 0.f;
#pragma unroll
    for (int j = 0; j < 4; ++j) { if (s - 3 + j >= 0) { const uint4 u = *(const uint4*)(qkraw + (size_t)(m - 3 + j) * 1024 + c0); const float4 w0 = *(const float4*)(cw + j * 1024 + c0), w1 = *(const float4*)(cw + j * 1024 + c0 + 4);
            acc[0] += w0.x * lo16(u.x); acc[1] += w0.y * hi16(u.x); acc[2] += w0.z * lo16(u.y); acc[3] += w0.w * hi16(u.y); acc[4] += w1.x * lo16(u.z); acc[5] += w1.y * hi16(u.z); acc[6] += w1.z * lo16(u.w); acc[7] += w1.w * hi16(u.w); } }
#pragma unroll
    for (int e = 0; e < 8; ++e) acc[e] = acc[e] * sigmoidf_(acc[e]);
    const int cc = c0 & 511, hh = cc >> 7, d = cc & 127;
    uint4 o; o.x = pk2(acc[0], acc[1]); o.y = pk2(acc[2], acc[3]); o.z = pk2(acc[4], acc[5]); o.w = pk2(acc[6], acc[7]);
    *(uint4*)((c0 < 512 ? qm : km) + ((size_t)(b * 4 + hh) * 2048 + s) * 128 + d) = o;
}
__device__ __forceinline__ void conv_silu_run(int item, const bf16* qkraw, const float* cw, bf16* qm, bf16* km) {
    const int cg = item & 127, c0 = cg * 8, m0 = (item >> 7) * 16, b = m0 >> 11, s0 = m0 & 2047;
    float w[4][8];
#pragma unroll
    for (int j = 0; j < 4; ++j) { const float4 w0 = *(const float4*)(cw + j * 1024 + c0), w1 = *(const float4*)(cw + j * 1024 + c0 + 4);
        w[j][0] = w0.x; w[j][1] = w0.y; w[j][2] = w0.z; w[j][3] = w0.w; w[j][4] = w1.x; w[j][5] = w1.y; w[j][6] = w1.z; w[j][7] = w1.w; }
    uint4 r0, r1, r2;
    const uint4 z4 = make_uint4(0u, 0u, 0u, 0u);
    r0 = s0 >= 3 ? *(const uint4*)(qkraw + (size_t)(m0 - 3) * 1024 + c0) : z4;
    r1 = s0 >= 2 ? *(const uint4*)(qkraw + (size_t)(m0 - 2) * 1024 + c0) : z4;
    r2 = s0 >= 1 ? *(const uint4*)(qkraw + (size_t)(m0 - 1) * 1024 + c0) : z4;
    const int cc = c0 & 511, hh = cc >> 7, d = cc & 127;
    bf16* dst = (c0 < 512 ? qm : km) + ((size_t)(b * 4 + hh) * 2048 + s0) * 128 + d;
    uint4 rr[16];
#pragma unroll
    for (int t = 0; t < 16; ++t) rr[t] = *(const uint4*)(qkraw + (size_t)(m0 + t) * 1024 + c0);
    float f[19][8];
#define CV_UNP(F, R) F[0] = lo16(R.x); F[1] = hi16(R.x); F[2] = lo16(R.y); F[3] = hi16(R.y); F[4] = lo16(R.z); F[5] = hi16(R.z); F[6] = lo16(R.w); F[7] = hi16(R.w);
    CV_UNP(f[0], r0) CV_UNP(f[1], r1) CV_UNP(f[2], r2)
#pragma unroll
    for (int t = 0; t < 16; ++t) { CV_UNP(f[t + 3], rr[t])
        float acc[8];
#pragma unroll
        for (int e = 0; e < 8; ++e) acc[e] = w[0][e] * f[t][e] + w[1][e] * f[t + 1][e] + w[2][e] * f[t + 2][e] + w[3][e] * f[t + 3][e];
#pragma unroll
        for (int e = 0; e < 8; ++e) acc[e] = acc[e] * sigmoidf_(acc[e]);
        uint4 o; o.x = pk2(acc[0], acc[1]); o.y = pk2(acc[2], acc[3]); o.z = pk2(acc[4], acc[5]); o.w = pk2(acc[6], acc[7]);
        *(uint4*)(dst + (size_t)t * 128) = o; }
#undef CV_UNP
}
__device__ __forceinline__ void gates_block(int bh, int tid, const float* ifr, const float* gb, float* li, float* bc, LAS float* xs  ) {
    const int b = bh >> 2, h = bh & 3, lane = tid & 63, w = tid >> 6; const float gbi = gb[h], gbf = gb[4 + h];
    float pi[4], lf[4], tot = 0.f;
#pragma unroll
    for (int i = 0; i < 4; ++i) { const size_t m = (size_t)b * 2048 + tid * 4 + i;
        const float xi = (ifr[m * 8 + h] + gbi) * (2.f / 15.f), xf = (ifr[m * 8 + 4 + h] + gbf) * (2.f / 15.f);
        pi[i] = 15.f - 30.f * __builtin_amdgcn_rcpf(1.f + __expf(xi)); const float pf = 15.f - 30.f * __builtin_amdgcn_rcpf(1.f + __expf(xf));
        lf[i] = -__logf(1.f + __expf(-pf)); tot += lf[i]; }
    float inc = tot;
#pragma unroll
    for (int o = 1; o < 64; o <<= 1) { const float t = __shfl_up(inc, o); if (lane >= o) inc += t; }
    if (lane == 63) xs[w] = inc;
    __syncthreads();
    float carry = 0.f;
#pragma unroll
    for (int q = 0; q < 8; ++q) carry += (q < w) ? xs[q] : 0.f;
    float run = carry + inc - tot;
#pragma unroll
    for (int i = 0; i < 4; ++i) { run += lf[i]; bc[bh * 2048 + tid * 4 + i] = run; li[bh * 2048 + tid * 4 + i] = pi[i]; }
    __syncthreads();
}
__device__ __forceinline__ void gates_wave(int bh, int lane, const float* ifr, const float* gb, float* li, float* bc) {
    const int b = bh >> 2, h = bh & 3; const float gbi = gb[h], gbf = gb[4 + h];
    float lf[32]; float tot = 0.f;
#pragma unroll
    for (int i = 0; i < 32; ++i) { const size_t m = (size_t)b * 2048 + lane * 32 + i;
        const float pi = 15.f * tanhf((ifr[m * 8 + h] + gbi) * (1.f / 15.f)), pf = 15.f * tanhf((ifr[m * 8 + 4 + h] + gbf) * (1.f / 15.f));
        li[bh * 2048 + lane * 32 + i] = pi; lf[i] = -log1pf(__expf(-pf)); tot += lf[i]; }
    float inc = tot;
#pragma unroll
    for (int o = 1; o < 64; o <<= 1) { const float t = __shfl_up(inc, o); if (lane >= o) inc += t; }
    float run = inc - tot;
#pragma unroll
    for (int i = 0; i < 32; ++i) { run += lf[i]; bc[bh * 2048 + lane * 32 + i] = run; }
}
__device__ __forceinline__ void rotary_elem(size_t idx, const bf16* src, bf16* dst, const float2* rot) {
    const size_t r = idx >> 6; const int i = (int)(idx & 63);
    const float2 cs = rot[(r & 2047) * 64 + i];
    const float x1 = bf2f(src[r * 128 + i]), x2 = bf2f(src[r * 128 + 64 + i]);
    dst[r * 128 + i] = f2bf(x1 * cs.x - x2 * cs.y); dst[r * 128 + 64 + i] = f2bf(x2 * cs.x + x1 * cs.y);
}

__device__ __forceinline__ float dot_qk(const volatile float* qs, const bf16* krow) {
    float acc = 0.f;
#pragma unroll
    for (int i = 0; i < 16; ++i) { const uint4 u = ((const uint4*)krow)[i];
        acc += qs[8 * i] * lo16(u.x) + qs[8 * i + 1] * hi16(u.x) + qs[8 * i + 2] * lo16(u.y) + qs[8 * i + 3] * hi16(u.y) + qs[8 * i + 4] * lo16(u.z) + qs[8 * i + 5] * hi16(u.z) + qs[8 * i + 6] * lo16(u.w) + qs[8 * i + 7] * hi16(u.w); }
    return acc;
}
__device__ __forceinline__ void pv_accum(float& a0, float& a1, float p, const bf16* v0, const bf16* v1, volatile float* pl, int lane) {
    pl[lane] = p;
#pragma unroll
    for (int i = 0; i < 8; ++i) { const uint4 u = ((const uint4*)v0)[i], w = ((const uint4*)v1)[i];
        const float p0 = pl[8 * i], p1 = pl[8 * i + 1], p2 = pl[8 * i + 2], p3 = pl[8 * i + 3], p4 = pl[8 * i + 4], p5 = pl[8 * i + 5], p6 = pl[8 * i + 6], p7 = pl[8 * i + 7];
        a0 += p0 * lo16(u.x) + p1 * hi16(u.x) + p2 * lo16(u.y) + p3 * hi16(u.y) + p4 * lo16(u.z) + p5 * hi16(u.z) + p6 * lo16(u.w) + p7 * hi16(u.w);
        a1 += p0 * lo16(w.x) + p1 * hi16(w.x) + p2 * lo16(w.y) + p3 * hi16(w.y) + p4 * lo16(w.z) + p5 * hi16(w.z) + p6 * lo16(w.w) + p7 * hi16(w.w); }
}
__device__ __forceinline__ void osm_step(float sc, bool valid, float& mrun, float& lrun, float& a0, float& a1, const bf16* v0, const bf16* v1, volatile float* pl, int lane) {
    const float cm = wave_max(valid ? sc : -3e38f);
    if (cm < -1e38f) return;
    const float mn = fmaxf(mrun, cm), alpha = __expf(mrun - mn);
    const float p = valid ? __expf(sc - mn) : 0.f;
    lrun = lrun * alpha + wave_sum(p); a0 *= alpha; a1 *= alpha; mrun = mn;
    pv_accum(a0, a1, p, v0, v1, pl, lane);
}
__device__ __forceinline__ void mlstm_query(int gid, int lane, volatile float* qs, const bf16* QM, const bf16* KM, const bf16* VMT, const float* LI, const float* BC, const bf16* OM, const float* gain, bf16* Y0) {
    const int t = gid & 2047, bh = gid >> 11;
    const bf16* qrow = QM + ((size_t)bh * 2048 + t) * 128;
    const float scale = 0.08838834764831845f;
    qs[2 * lane] = bf2f(qrow[2 * lane]) * scale; qs[2 * lane + 1] = bf2f(qrow[2 * lane + 1]) * scale;
    const float bt = BC[bh * 2048 + t];
    float n0 = 0.f, n1 = 0.f, den = 0.f;
    const bf16* v0 = VMT + ((size_t)bh * 128 + 2 * lane) * 2048; const bf16* v1 = v0 + 2048;
    for (int c = 0; c <= (t >> 6); ++c) {
        const int s = c * 64 + lane; float p = 0.f;
        if (s <= t) { const float d = dot_qk(qs, KM + ((size_t)bh * 2048 + s) * 128); p = d * __expf(bt - BC[bh * 2048 + s] + LI[bh * 2048 + s]); }
        den += p;
        pv_accum(n0, n1, p, v0 + c * 64, v1 + c * 64, qs + 128, lane);
    }
    den = wave_sum(den);
    const float dn = fmaxf(fabsf(den), 1.f), h0 = n0 / dn, h1 = n1 / dn;
    const float ms = wave_sum(h0 * h0 + h1 * h1) * (1.f / 128.f), r = rsqrtf(ms + 1e-6f);
    const int b = bh >> 2, h = bh & 3, col = h * 128 + 2 * lane; const size_t m = (size_t)b * 2048 + t;
    const float y0 = h0 * r * gain[col] * sigmoidf_(bf2f(OM[m * 512 + col])), y1 = h1 * r * gain[col + 1] * sigmoidf_(bf2f(OM[m * 512 + col + 1]));
    *(unsigned*)(Y0 + m * 1024 + col) = (unsigned)f2bf(y0) | ((unsigned)f2bf(y1) << 16);
}
__device__ __forceinline__ void moba_query(int gid, int lane, volatile float* qs, const bf16* QB, const bf16* KB, const bf16* VBT, bf16* Y0) {
    const int t = gid & 2047, bh = gid >> 11;
    const bf16* qrow = QB + ((size_t)bh * 2048 + t) * 128;
    qs[2 * lane] = bf2f(qrow[2 * lane]); qs[2 * lane + 1] = bf2f(qrow[2 * lane + 1]);
    const int cur = t >> 8;
    float gv = NEGINF;
    {
        for (int n = 0; n < cur; ++n) {
            float s0 = 0.f, s1 = 0.f; const bf16* kp = KB + ((size_t)bh * 2048 + n * 256) * 128 + 2 * lane;
            for (int j = 0; j < 256; ++j) { const unsigned u = *(const unsigned*)(kp + (size_t)j * 128); s0 += lo16(u); s1 += hi16(u); }
            const float part = wave_sum(qs[2 * lane] * (s0 * (1.f / 256.f)) + qs[2 * lane + 1] * (s1 * (1.f / 256.f)));
            if (lane == n) gv = part;
        }
    }
    unsigned selmask = 0u; float gcur = (lane < 8) ? gv : -3e38f;
    for (int r = 0; r < 3; ++r) {
        const float mx = wave_max(gcur);
        const unsigned long long bal = __ballot(gcur == mx);
        const int win = __ffsll((long long)bal) - 1;
        if (mx > 0.5f * NEGINF) selmask |= 1u << win;
        if (lane == win) gcur = -3e38f;
    }
    const float scale = 0.08838834764831845f;
    float mrun = -3e38f, lrun = 0.f, a0 = 0.f, a1 = 0.f;
    const bf16* v0 = VBT + ((size_t)bh * 128 + 2 * lane) * 2048; const bf16* v1 = v0 + 2048;
    for (int n = 0; n <= cur; ++n) {
        if (n != cur && !((selmask >> n) & 1u)) continue;
        for (int c = 0; c < 4; ++c) {
            const int s = n * 256 + c * 64 + lane;
            if (n * 256 + c * 64 > t) break;
            const bool valid = s <= t;
            float sc = 0.f; if (valid) sc = dot_qk(qs, KB + ((size_t)bh * 2048 + s) * 128) * scale;
            osm_step(sc, valid, mrun, lrun, a0, a1, v0 + n * 256 + c * 64, v1 + n * 256 + c * 64, qs + 128, lane);
        }
    }
    const float inv = 1.f / fmaxf(lrun, 1e-30f);
    const int b = bh >> 2, h = bh & 3, col = 512 + h * 128 + 2 * lane; const size_t m = (size_t)b * 2048 + t;
    *(unsigned*)(Y0 + m * 1024 + col) = (unsigned)f2bf(a0 * inv) | ((unsigned)f2bf(a1 * inv) << 16);
}
__device__ __forceinline__ void nsa_cmp_query(int gid, int lane, volatile float* Q, volatile float* P, const bf16* Q1, const bf16* KCMP, const bf16* VCMPT, bf16* OC, unsigned* SELM) {
    const int s = gid & 2047, bg = gid >> 11, b = bg >> 1, g = bg & 1;
    const float scale = 0.08838834764831845f;
    float imp0 = 0.f, imp1 = 0.f;
    for (int r = 0; r < 4; ++r) {
        const bf16* qrow = Q1 + ((size_t)(b * 8 + g * 4 + r) * 2048 + s) * 128;
        Q[2 * lane] = bf2f(qrow[2 * lane]); Q[2 * lane + 1] = bf2f(qrow[2 * lane + 1]);
        const int n0 = lane, n1 = lane + 64;
        const bool ok0 = (16 * n0 + 31) <= s, ok1 = (n1 < 127) && ((16 * n1 + 31) <= s);
        float s0 = 0.f, s1 = 0.f;
        if (ok0) s0 = dot_qk(Q, KCMP + ((size_t)bg * 128 + n0) * 128) * scale;
        if (ok1) s1 = dot_qk(Q, KCMP + ((size_t)bg * 128 + n1) * 128) * scale;
        const float mx = wave_max(fmaxf(ok0 ? s0 : -3e38f, ok1 ? s1 : -3e38f));
        const float p0 = ok0 ? __expf(s0 - mx) : 0.f, p1 = ok1 ? __expf(s1 - mx) : 0.f;
        const float sum = wave_sum(p0 + p1), inv = 1.f / fmaxf(sum, 1e-30f);
        const float q0 = p0 * inv, q1 = p1 * inv;
        imp0 += q0; imp1 += q1;
        P[n0] = q0; P[n1] = q1;
        float a0 = 0.f, a1 = 0.f;
        const bf16* v0 = VCMPT + ((size_t)bg * 128 + 2 * lane) * 128; const bf16* v1 = v0 + 128;
        for (int n = 0; n < 127; ++n) { const float p = P[n]; a0 += p * bf2f(v0[n]); a1 += p * bf2f(v1[n]); }
        const size_t m = (size_t)b * 2048 + s; const int col = (g * 4 + r) * 128 + 2 * lane;
        *(unsigned*)(OC + m * 1024 + col) = (unsigned)f2bf(a0) | ((unsigned)f2bf(a1) << 16);
    }
    P[lane] = imp0; P[lane + 64] = imp1;
    const int cur = s >> 6;
    float val = -3e38f;
    if (lane < 32) { const int j = lane; float im = 0.f;
        for (int n = 4 * j - 1; n <= 4 * j + 3; ++n) if (n >= 0 && n < 127) im += P[n];
        const bool forced = (j == 0) || (j == cur) || (j == cur - 1);
        val = (j <= cur) ? (forced ? 1e4f : im) : NEGINF; }
    unsigned mask = 0u;
    for (int r = 0; r < 8; ++r) {
        const float mx = wave_max(val);
        const unsigned long long bal = __ballot(val == mx);
        const int win = __ffsll((long long)bal) - 1;
        if (mx > 0.5f * NEGINF) mask |= 1u << win;
        if (lane == win) val = -3e38f;
    }
    if (lane == 0) SELM[bg * 2048 + s] = mask;
}
__device__ __forceinline__ void nsa_selwin_query(int gid, int lane, volatile float* qs, const bf16* Q1R, const bf16* KS, const bf16* VST, const bf16* KW, const bf16* VWT, const bf16* OC, const unsigned* SELM, const float* G, bf16* Y1) {
    const int s = gid & 2047, bh = gid >> 11, b = bh >> 3, hd = bh & 7, bg = b * 2 + (hd >> 2);
    const bf16* qrow = Q1R + ((size_t)bh * 2048 + s) * 128;
    qs[2 * lane] = bf2f(qrow[2 * lane]); qs[2 * lane + 1] = bf2f(qrow[2 * lane + 1]);
    const float scale = 0.08838834764831845f;
    const unsigned mask = SELM[bg * 2048 + s];
    const int cur = s >> 6;
    float os0, os1, ow0, ow1;
    {   float mrun = -3e38f, lrun = 0.f, a0 = 0.f, a1 = 0.f;
        const bf16* v0 = VST + ((size_t)bg * 128 + 2 * lane) * 2048; const bf16* v1 = v0 + 2048;
        for (int j = 0; j <= cur; ++j) { if (!((mask >> j) & 1u)) continue;
            const int k = j * 64 + lane; const bool valid = k <= s;
            float sc = 0.f; if (valid) sc = dot_qk(qs, KS + ((size_t)bg * 2048 + k) * 128) * scale;
            osm_step(sc, valid, mrun, lrun, a0, a1, v0 + j * 64, v1 + j * 64, qs + 128, lane); }
        const float inv = 1.f / fmaxf(lrun, 1e-30f); os0 = a0 * inv; os1 = a1 * inv; }
    {   float mrun = -3e38f, lrun = 0.f, a0 = 0.f, a1 = 0.f;
        const bf16* v0 = VWT + ((size_t)bg * 128 + 2 * lane) * 2048; const bf16* v1 = v0 + 2048;
        for (int j = (cur >= 8 ? cur - 8 : 0); j <= cur; ++j) {
            const int k = j * 64 + lane; const bool valid = (k <= s) && (s - k < 512);
            float sc = 0.f; if (valid) sc = dot_qk(qs, KW + ((size_t)bg * 2048 + k) * 128) * scale;
            osm_step(sc, valid, mrun, lrun, a0, a1, v0 + j * 64, v1 + j * 64, qs + 128, lane); }
        const float inv = 1.f / fmaxf(lrun, 1e-30f); ow0 = a0 * inv; ow1 = a1 * inv; }
    const size_t m = (size_t)b * 2048 + s; const int col = hd * 128 + 2 * lane;
    const float g0 = G[m * 24 + hd * 3], g1 = G[m * 24 + hd * 3 + 1], g2 = G[m * 24 + hd * 3 + 2];
    const unsigned oc = *(const unsigned*)(OC + m * 1024 + col);
    const float y0 = g0 * lo16(oc) + g1 * os0 + g2 * ow0, y1 = g0 * hi16(oc) + g1 * os1 + g2 * ow1;
    *(unsigned*)(Y1 + m * 1024 + col) = (unsigned)f2bf(y0) | ((unsigned)f2bf(y1) << 16);
}

constexpr size_t WB_W0T = 0;
constexpr size_t WB_WO0T = WB_W0T + (size_t)3584 * 1024;
constexpr size_t WB_W13T0 = WB_WO0T + (size_t)1024 * 1024;
constexpr size_t WB_W2T0 = WB_W13T0 + (size_t)16 * 512 * 1024;
constexpr size_t WB_W1T = WB_W2T0 + (size_t)16 * 1024 * 256;
constexpr size_t WB_WO1T = WB_W1T + (size_t)2560 * 1024;
constexpr size_t WB_W13T1 = WB_WO1T + (size_t)1024 * 1024;
constexpr size_t WB_W2T1 = WB_W13T1 + (size_t)16 * 512 * 1024;
constexpr size_t WB_CK1T = WB_W2T1 + (size_t)16 * 1024 * 256;
constexpr size_t WB_CV1T = WB_CK1T + (size_t)256 * 4096;
constexpr size_t WB_CK2T = WB_CV1T + (size_t)256 * 4096;
constexpr size_t WB_CV2T = WB_CK2T + (size_t)128 * 256;
constexpr size_t WB_END = WB_CV2T + (size_t)128 * 256;
static_assert(WS_WB + WB_END * 2 <= WS_R0, "bf16 weights fit");

typedef unsigned v4u __attribute__((ext_vector_type(4)));
__device__ __forceinline__ int rot_feat(int p) { return (p & ~127) + 4 * ((p & 127) >> 3) + (p & 3) + 64 * ((p >> 2) & 1); }
template <bool ROTP>
__device__ __forceinline__ void transpose_item(const float* W, int ldw, int col0, int K, bf16* WT, int row0, int kb, int nb, LAS float* scr, int lane) {
    const int k0 = 64 * kb, n0 = 32 * nb; const int nl = n0 + (lane & 31), sc = col0 + (ROTP ? rot_feat(nl) : nl);
#pragma unroll 8
    for (int i = 0; i < 32; ++i) { const int kk = 2 * i + (lane >> 5); scr[kk * 33 + (lane & 31)] = W[(size_t)(k0 + kk) * ldw + sc]; }
    asm volatile("s_waitcnt lgkmcnt(0)" ::: "memory");
    const int c = lane & 7;
#pragma unroll
    for (int j = 0; j < 4; ++j) { const int n = (lane >> 3) + 8 * j; const LAS float* s = scr + (8 * c) * 33 + n;
        v4u o; o.x = pk2(s[0 * 33], s[1 * 33]); o.y = pk2(s[2 * 33], s[3 * 33]); o.z = pk2(s[4 * 33], s[5 * 33]); o.w = pk2(s[6 * 33], s[7 * 33]);
        *(v4u*)(WT + (size_t)(row0 + n0 + n) * K + k0 + 8 * c) = o; }
    asm volatile("s_waitcnt lgkmcnt(0)" ::: "memory");
}
template <int MODE>
__device__ __forceinline__ void transpose_block(const float* W, int ldw, int col0, int K, bf16* WT, int row0, int kb, int ncols, LAS float* scr, int tid, const float* kscale = nullptr) {
    const int wave = tid >> 6, lane = tid & 63, k0 = 64 * kb;
    __syncthreads();
    if (4 * lane < ncols) {
        int pos = 4 * lane;
        if (MODE == 1) { const int f = pos & 127; pos = (pos & ~127) + (f < 64 ? 8 * (f >> 2) : 8 * ((f - 64) >> 2) + 4); }
        typedef float f4v __attribute__((ext_vector_type(4)));
        f4v v[8];
#pragma unroll
        for (int i = 0; i < 8; ++i) v[i] = __builtin_nontemporal_load((const f4v*)(W + (size_t)(k0 + wave * 8 + i) * ldw + col0 + 4 * lane));
#pragma unroll
        for (int i = 0; i < 8; ++i) { LAS float* d = scr + (wave * 8 + i) * 257 + pos; const float ks = kscale ? kscale[k0 + wave * 8 + i] : 1.f; d[0] = v[i][0] * ks; d[1] = v[i][1] * ks; d[2] = v[i][2] * ks; d[3] = v[i][3] * ks; }
    }
    __syncthreads();
    const int c = lane & 7;
#pragma unroll
    for (int j = 0; j < 4; ++j) { const int d = wave * 32 + 8 * j + (lane >> 3);
        if (d < ncols) { const LAS float* sp = scr + (8 * c) * 257 + d;
            v4u o; o.x = pk2(sp[0 * 257], sp[1 * 257]); o.y = pk2(sp[2 * 257], sp[3 * 257]); o.z = pk2(sp[4 * 257], sp[5 * 257]); o.w = pk2(sp[6 * 257], sp[7 * 257]);
            const int drow = row0 + (MODE == 2 ? ((d >> 7) * 256 + (d & 127)) : d);
            *(v4u*)(WT + (size_t)drow * K + k0 + 8 * c) = o; } }
}
#define BSEG(W, ldw, col0, K, ncols, WT, row0, MODE) { const int _nbk = ((ncols) + 255) / 256, _ni = ((K) / 64) * _nbk; if (r < _ni) { const int _nb = r % _nbk; \
    transpose_block<MODE>(W, ldw, (col0) + 256 * _nb, K, WT, (row0) + 256 * _nb, r / _nbk, (ncols) < 256 ? (ncols) : 256, scr, tid); continue; } r -= _ni; }
#define CONV_SEG(W, ldw, col0, K, ncols, WT, row0) { const int _ni = ((K) / 64) * ((ncols) / 32); if (r < _ni) { const int _nb = (ncols) / 32; transpose_item<false>(W, ldw, col0, K, WT, row0, r / _nb, r % _nb, scr, lane); continue; } r -= _ni; }
#define CONV_SEG_ROT(W, ldw, col0, K, ncols, WT, row0) { const int _ni = ((K) / 64) * ((ncols) / 32); if (r < _ni) { const int _nb = (ncols) / 32; transpose_item<true>(W, ldw, col0, K, WT, row0, r / _nb, r % _nb, scr, lane); continue; } r -= _ni; }

struct TBlk { const float* src; bf16* dst; const float* ks; int ldw, K, ncols, mode; };
typedef float tbf4 __attribute__((ext_vector_type(4)));
__device__ __forceinline__ TBlk tb_make(const float* W, int ldw, int col0, int K, bf16* WT, int row0, int kb, int ncols, int mode, const float* kscale = nullptr) {
    TBlk t; t.src = W + (size_t)(64 * kb) * ldw + col0; t.dst = WT + (size_t)row0 * K + 64 * kb; t.ks = kscale ? kscale + 64 * kb : nullptr; t.ldw = ldw; t.K = K; t.ncols = ncols; t.mode = mode; return t; }
__device__ __forceinline__ void tb_load(const TBlk& t, tbf4 (&v)[8], float (&ks)[8], int wave, int lane) {
    if (4 * lane < t.ncols) {
#pragma unroll
        for (int i = 0; i < 8; ++i) v[i] = __builtin_nontemporal_load((const tbf4*)(t.src + (size_t)(wave * 8 + i) * t.ldw + 4 * lane)); }
#pragma unroll
    for (int i = 0; i < 8; ++i) ks[i] = t.ks ? t.ks[wave * 8 + i] : 1.f;
}
__device__ __forceinline__ void tb_put(const TBlk& t, const tbf4 (&v)[8], const float (&ks)[8], LAS float* scr, int wave, int lane) {
    if (4 * lane < t.ncols) {
        int pos = 4 * lane;
        if (t.mode == 1) { const int f = pos & 127; pos = (pos & ~127) + (f < 64 ? 8 * (f >> 2) : 8 * ((f - 64) >> 2) + 4); }
#pragma unroll
        for (int i = 0; i < 8; ++i) { LAS float* d = scr + (wave * 8 + i) * 257 + pos; d[0] = v[i][0] * ks[i]; d[1] = v[i][1] * ks[i]; d[2] = v[i][2] * ks[i]; d[3] = v[i][3] * ks[i]; } }
}
__device__ __forceinline__ void tb_get(const TBlk& t, const LAS float* scr, int wave, int lane) {
    const int c = lane & 7;
#pragma unroll
    for (int j = 0; j < 4; ++j) { const int d = wave * 32 + 8 * j + (lane >> 3);
        if (d < t.ncols) { const LAS float* sp = scr + (8 * c) * 257 + d;
            v4u o; o.x = pk2(sp[0 * 257], sp[1 * 257]); o.y = pk2(sp[2 * 257], sp[3 * 257]); o.z = pk2(sp[4 * 257], sp[5 * 257]); o.w = pk2(sp[6 * 257], sp[7 * 257]);
            const int drow = t.mode == 2 ? ((d >> 7) * 256 + (d & 127)) : d;
            *(v4u*)(t.dst + (size_t)drow * t.K + 8 * c) = o; } }
}
#define TSEG(out, W, ldw, col0, K, ncols, WT, row0, MODE) { const int _nbk = ((ncols) + 255) / 256, _ni = ((K) / 64) * _nbk; if (r < _ni) { const int _nb = r % _nbk; \
    out = tb_make(W, ldw, (col0) + 256 * _nb, K, WT, (row0) + 256 * _nb, r / _nbk, (ncols) < 256 ? (ncols) : 256, MODE); break; } r -= _ni; }
#define TMOE13(out, L, q) { const int q_ = (q), which_ = q_ >> 8, e_ = (q_ >> 4) & 15, kb_ = q_ & 15; const float* src_ = ((L) == 0 ? (which_ ? in[13] : in[12]) : (which_ ? in[29] : in[28])) + (size_t)e_ * 1024 * 256; \
    out = tb_make(src_, 256, 0, 1024, WB + ((L) == 0 ? WB_W13T0 : WB_W13T1) + (size_t)e_ * 512 * 1024, which_ * 128, kb_, 256, 2, (L) == 0 ? in[7] : in[23]); }
#define TMOE2(out, L, q2) { const int q_ = (q2), e_ = q_ >> 4, kb_ = (q_ >> 2) & 3, nb_ = q_ & 3; const float* src_ = ((L) == 0 ? in[14] : in[30]) + (size_t)e_ * 256 * 1024; \
    out = tb_make(src_, 1024, 256 * nb_, 256, WB + ((L) == 0 ? WB_W2T0 : WB_W2T1) + (size_t)e_ * 1024 * 256, 256 * nb_, kb_, 256, 0); }
#define DEC_P0(i_, out) do { int r = (i_); \
    TSEG(out, in[2], 3592, 0, 1024, 1024, WB + WB_W0T, 0, 0) TSEG(out, in[2], 3592, 1536, 1024, 512, WB + WB_W0T, 1024, 0) TSEG(out, in[2], 3592, 2056, 1024, 512, WB + WB_W0T, 1536, 1) \
    TSEG(out, in[2], 3592, 2568, 1024, 512, WB + WB_W0T, 2048, 1) TSEG(out, in[2], 3592, 1024, 1024, 512, WB + WB_W0T, 2560, 0) TSEG(out, in[2], 3592, 3080, 1024, 512, WB + WB_W0T, 3072, 0) } while (0)
#define DEC_P1(i_, out) do { int r = (i_); TSEG(out, in[6], 1024, 0, 1024, 1024, WB + WB_WO0T, 0, 0) TMOE13(out, 0, r) } while (0)
#define DEC_W2T0(i_, out) do { TMOE2(out, 0, (i_)) } while (0)
#define DEC_P7(i_, out) do { int r = (i_); \
    TSEG(out, in[16], 2584, 0, 1024, 1536, WB + WB_W1T, 0, 0) TSEG(out, in[16], 2584, 1536, 1024, 256, WB + WB_W1T, 1536, 1) TSEG(out, in[16], 2584, 2048, 1024, 256, WB + WB_W1T, 1792, 1) \
    TSEG(out, in[16], 2584, 1792, 1024, 256, WB + WB_W1T, 2048, 0) TSEG(out, in[16], 2584, 2304, 1024, 256, WB + WB_W1T, 2304, 0) TSEG(out, in[22], 1024, 0, 1024, 1024, WB + WB_WO1T, 0, 0) \
    TSEG(out, in[18], 256, 0, 4096, 256, WB + WB_CK1T, 0, 0) TSEG(out, in[20], 256, 0, 4096, 256, WB + WB_CV1T, 0, 0) TMOE13(out, 1, r) } while (0)
#define DEC_M1(i_, out) do { const int qq_ = (i_); if (qq_ < 512) TMOE13(out, 1, qq_) else TMOE2(out, 1, qq_ - 512) } while (0)
#define CONV_RUN(first, end, step, DEC) do { const int e__ = (end), st__ = (step); int it__ = (first); if (it__ < e__) { TBlk cur__, nxt__; tbf4 v__[8]; float ks__[8]; DEC(it__, cur__); tb_load(cur__, v__, ks__, wave, lane); \
    for (; it__ < e__; it__ += st__) { __syncthreads(); tb_put(cur__, v__, ks__, scr, wave, lane); __syncthreads(); nxt__ = cur__; \
        if (it__ + st__ < e__) { DEC(it__ + st__, nxt__); tb_load(nxt__, v__, ks__, wave, lane); } tb_get(cur__, scr, wave, lane); cur__ = nxt__; } } } while (0)

__device__ __forceinline__ bool fill_slot(int nun, int G, int idx, int& slot, int& nslots) {
    const int rem = nun % G;
    if (rem == 0 || G - rem < G / 4) { slot = idx; nslots = G; return true; }
    if (idx < rem) return false;
    slot = idx - rem; nslots = G - rem; return true;
}
#define MOE13_BLOCK(L, q) { const int which_ = (q) >> 8, e_ = ((q) >> 4) & 15, kb_ = (q) & 15; const float* src_ = ((L) == 0 ? (which_ ? in[13] : in[12]) : (which_ ? in[29] : in[28])) + (size_t)e_ * 1024 * 256; \
    transpose_block<2>(src_, 256, 0, 1024, WB + ((L) == 0 ? WB_W13T0 : WB_W13T1) + (size_t)e_ * 512 * 1024, which_ * 128, kb_, 256, scr, tid, (L) == 0 ? in[7] : in[23]); }
#define MOE2_BLOCK(L, q2) { const int e_ = (q2) >> 4, kb_ = ((q2) >> 2) & 3, nb_ = (q2) & 3; const float* src_ = ((L) == 0 ? in[14] : in[30]) + (size_t)e_ * 256 * 1024; \
    transpose_block<0>(src_, 1024, 256 * nb_, 256, WB + ((L) == 0 ? WB_W2T0 : WB_W2T1) + (size_t)e_ * 1024 * 256, 256 * nb_, kb_, 256, scr, tid); }
constexpr int F8_BLOCKS = 224, F11_BLOCKS = 256;

namespace pg {
typedef short bf16x8 __attribute__((ext_vector_type(8)));
typedef float f32x4 __attribute__((ext_vector_type(4)));
typedef unsigned u32x4 __attribute__((ext_vector_type(4)));
__device__ __forceinline__ void st16_wt(void* p, const u32x4& v) { asm volatile("global_store_dwordx4 %0, %1, off sc1\n\ts_nop 1" :: "v"(p), "v"(v)); }
constexpr int BM = 256, BK = 64, HALF = 128, HTB = HALF * BK * 2, STAGE_BYTES = 8 * HTB, NXCD = 8, WGM = 8;
__device__ __forceinline__ int lds_byte(int r, int c) { const int st = (r >> 4) * 2 + (c >> 5), rr = r & 15, cc = c & 31, ob = rr * 64 + cc * 2; return st * 1024 + (ob ^ (((ob >> 9) & 1) << 5)); }
__device__ __forceinline__ void stage_rc(int b, int& R, int& C) { const int st = b / 1024, sb = b % 1024, swz = sb ^ (((sb >> 9) & 1) << 5); R = (st >> 1) * 16 + swz / 64; C = (st & 1) * 32 + (swz % 64) / 2; }
__device__ __forceinline__ int perm32(int rho) { const int n = rho >> 4, i = rho & 15; return 8 * (i >> 2) + 4 * n + (i & 3); }
__device__ __forceinline__ const char* uptr(const char* p) { const unsigned long long v = (unsigned long long)p; const unsigned lo = __builtin_amdgcn_readfirstlane((unsigned)v), hi = __builtin_amdgcn_readfirstlane((unsigned)(v >> 32)); return (const char*)(((unsigned long long)hi << 32) | lo); }
__device__ __forceinline__ unsigned cvt_pk_bf16(float lo, float hi) { unsigned r; asm volatile("v_cvt_pk_bf16_f32 %0, %1, %2" : "=v"(r) : "v"(lo), "v"(hi)); return r; }
__device__ __forceinline__ u32x4 pack8(const f32x4& a, const f32x4& b) { u32x4 w; w.x = cvt_pk_bf16(a[0], a[1]); w.y = cvt_pk_bf16(a[2], a[3]); w.z = cvt_pk_bf16(b[0], b[1]); w.w = cvt_pk_bf16(b[2], b[3]); return w; }

struct TileOrder {
    int nM, nN, nwg, G, c;
    __device__ void init(int nM_, int nN_, int G_, int c_) { nM = nM_; nN = nN_; nwg = nM * nN; G = G_; c = c_; }
    __device__ bool get(int i, int& pm, int& pn) const {
        const long L = (long)i * G + c; if (L >= nwg) return false;
        int wgid = (int)L; { const int q = nwg / NXCD, r = nwg % NXCD, xcd = wgid % NXCD, off = wgid / NXCD; wgid = (xcd < r ? xcd * (q + 1) : r * (q + 1) + (xcd - r) * q) + off; }
        const int nig = WGM * nN, gid = wgid / nig, fm = gid * WGM, gsz = (nM % WGM == 0) ? WGM : (nM < WGM ? nM : ((nM - fm) < WGM ? (nM - fm) : WGM));
        pm = fm + ((wgid % nig) % gsz); pn = (wgid % nig) / gsz; return true;
    }
};
struct UnitD { int pm, pn; };
struct DenseSched {
    typedef UnitD U;
    const bf16* A; int lda; const bf16* Bt; int K; TileOrder ord;
    __device__ bool next(int i, U& u) const { return ord.get(i, u.pm, u.pn); }
    __device__ void uni(U& u) const { u.pm = __builtin_amdgcn_readfirstlane(u.pm); u.pn = __builtin_amdgcn_readfirstlane(u.pn); }
    __device__ const char* abase(const U& u) const { return (const char*)(A + (size_t)u.pm * BM * lda); }
    __device__ unsigned aoff(const U&, int r, int c) const { return (unsigned)(r * lda + c) * 2u; }
    __device__ const char* bbase(const U& u) const { return (const char*)(Bt + (size_t)u.pn * BM * K); }
    __device__ void done(const U&) const {}
};

template <class Epi, class Sched>
__device__ __forceinline__ void gemm_phase(LAS unsigned char* lds, const int K, const Sched& S, const Epi& E, const int ldb_ = 0) {
    int tid = threadIdx.x; asm volatile("" : "+v"(tid));
    const int wid = __builtin_amdgcn_readfirstlane(tid >> 6), lane = tid & 63, wr = wid >> 2, wc = wid & 3, fr = lane & 15, fq = lane >> 4;
    const int nt = K / BK;
    int R[2], C[2]; unsigned vb[2][2];
#pragma unroll
    for (int i = 0; i < 2; ++i) { stage_rc(tid * 16 + i * 8192, R[i], C[i]); const int Rb = (R[i] & ~31) + perm32(R[i] & 31);
        const int ldb = ldb_ ? ldb_ : K; vb[0][i] = (unsigned)(Rb * ldb + C[i]) * 2u; vb[1][i] = (unsigned)((HALF + Rb) * ldb + C[i]) * 2u; }
    const size_t kstep = (size_t)(BK * 2);
    const unsigned ldsw = (unsigned)wid * 1024u;
    const unsigned ldsbase = __builtin_amdgcn_readfirstlane((unsigned)(size_t)lds + ldsw);
    const int aoff = lds_byte(wr * 64 + fr, fq * 8), boff = lds_byte(wc * 32 + fr, fq * 8);
#define PG_SA(b, h) (((b) * 2 + (h)) * HTB)
#define PG_SB(b, h) ((4 + (b) * 2 + (h)) * HTB)
#define PG_STAGE(bufoff, gbase, voff) do { _Pragma("unroll") for (int _i = 0; _i < 2; ++_i) { unsigned _keep; \
        asm volatile("s_mov_b32 %0, m0\n\ts_mov_b32 m0, %3\n\ts_nop 0\n\tglobal_load_lds_dwordx4 %1, %2\n\ts_mov_b32 m0, %0" \
            : "=&s"(_keep) : "v"((voff)[_i]), "s"(gbase), "s"(ldsbase + (unsigned)((bufoff) + _i * 8192)) : "memory"); } } while (0)
#define PG_LDA(dst, b, h) do { _Pragma("unroll") for (int m = 0; m < 4; ++m) _Pragma("unroll") for (int k = 0; k < 2; ++k) dst[m][k] = *(const LAS bf16x8*)(lds + PG_SA(b, h) + aoff + m * 2048 + k * 1024); } while (0)
#define PG_LDB(dst, b, h) do { _Pragma("unroll") for (int n = 0; n < 2; ++n) _Pragma("unroll") for (int k = 0; k < 2; ++k) dst[n][k] = *(const LAS bf16x8*)(lds + PG_SB(b, h) + boff + n * 2048 + k * 1024); } while (0)
#define PG_MMA(ai, bj, At, Bt) do { __builtin_amdgcn_s_setprio(1); _Pragma("unroll") for (int m = 0; m < 4; ++m) _Pragma("unroll") for (int n = 0; n < 2; ++n) _Pragma("unroll") for (int k = 0; k < 2; ++k) \
        acc[ai][bj][m][n] = __builtin_amdgcn_mfma_f32_16x16x32_bf16(Bt[n][k], At[m][k], acc[ai][bj][m][n], 0, 0, 0); __builtin_amdgcn_s_setprio(0); } while (0)
#define PG_WAIT_V(n) asm volatile("s_waitcnt vmcnt(" #n ")" ::: "memory")
#define PG_WAIT_L(n) asm volatile("s_waitcnt lgkmcnt(" #n ")" ::: "memory")
#define PG_BAR __builtin_amdgcn_s_barrier()
#define PG_SCHED __builtin_amdgcn_sched_barrier(0)
    typename Sched::U cur, nxt; int ui = 0;
    if (!S.next(0, cur)) return;
    S.uni(cur);
    f32x4 acc[2][2][4][2];
#pragma unroll
    for (int a = 0; a < 2; ++a)
#pragma unroll
        for (int b = 0; b < 2; ++b)
#pragma unroll
            for (int m = 0; m < 4; ++m)
#pragma unroll
                for (int n = 0; n < 2; ++n) acc[a][b][m][n] = (f32x4){0.f, 0.f, 0.f, 0.f};
    bf16x8 At[4][2], B0[2][2], B1[2][2];
    const char* cA = uptr(S.abase(cur)); const char* cB = uptr(S.bbase(cur));
    unsigned va[2][2];
#pragma unroll
    for (int h = 0; h < 2; ++h)
#pragma unroll
        for (int i = 0; i < 2; ++i) va[h][i] = S.aoff(cur, h * HALF + R[i], C[i]);
    PG_STAGE(PG_SB(0, 0), cB, vb[0]); PG_STAGE(PG_SB(0, 1), cB, vb[1]); PG_STAGE(PG_SA(0, 0), cA, va[0]); PG_STAGE(PG_SA(0, 1), cA, va[1]);
    if (wr == 1) PG_BAR;
    PG_WAIT_V(2); PG_BAR;
    {   const char* cA1 = uptr(cA + kstep); const char* cB1 = uptr(cB + kstep);
        PG_STAGE(PG_SB(1, 0), cB1, vb[0]); PG_STAGE(PG_SA(1, 0), cA1, va[0]); PG_STAGE(PG_SB(1, 1), cB1, vb[1]); }
    PG_WAIT_V(6); PG_BAR;
    for (;;) {
        const bool has_next = __builtin_amdgcn_readfirstlane((int)S.next(ui + 1, nxt)) != 0;
        S.uni(nxt);
        const char* nA = uptr(has_next ? S.abase(nxt) : cA); const char* nB = uptr(has_next ? S.bbase(nxt) : cB);
        for (int t = 0; t < nt; t += 2) {
            const bool last = (t == nt - 2);
            const char* a1 = cA + (size_t)(t + 1) * kstep;
            const char* a2 = last ? nA : cA + (size_t)(t + 2) * kstep; const char* b2 = last ? nB : cB + (size_t)(t + 2) * kstep;
            const char* a3 = a2 + kstep; const char* b3 = b2 + kstep;
            a1 = uptr(a1); a2 = uptr(a2); b2 = uptr(b2); a3 = uptr(a3); b3 = uptr(b3);
            unsigned nva[2][2];
            if (last && has_next) {
#pragma unroll
                for (int h = 0; h < 2; ++h)
#pragma unroll
                    for (int i = 0; i < 2; ++i) nva[h][i] = S.aoff(nxt, h * HALF + R[i], C[i]);
            }
            PG_LDB(B0, 0, 0); PG_LDB(B1, 0, 1); PG_SCHED; PG_LDA(At, 0, 0); PG_STAGE(PG_SA(1, 1), a1, va[1]);
            PG_WAIT_V(8); PG_WAIT_L(0); PG_BAR; PG_MMA(0, 0, At, B0); PG_MMA(0, 1, At, B1); PG_BAR; PG_SCHED;
            if (last && has_next) {
#pragma unroll
                for (int h = 0; h < 2; ++h)
#pragma unroll
                    for (int i = 0; i < 2; ++i) va[h][i] = nva[h][i];
            }
            PG_LDA(At, 0, 1); PG_STAGE(PG_SB(0, 0), b2, vb[0]); PG_STAGE(PG_SB(0, 1), b2, vb[1]); PG_STAGE(PG_SA(0, 0), a2, va[0]);
            PG_WAIT_V(8); PG_WAIT_L(0); PG_BAR; PG_MMA(1, 0, At, B0); PG_MMA(1, 1, At, B1); PG_BAR; PG_SCHED;
            PG_LDB(B0, 1, 0); PG_LDB(B1, 1, 1); PG_SCHED; PG_LDA(At, 1, 0); PG_STAGE(PG_SA(0, 1), a2, va[1]);
            PG_WAIT_V(8); PG_WAIT_L(0); PG_BAR; PG_MMA(0, 0, At, B0); PG_MMA(0, 1, At, B1); PG_BAR; PG_SCHED;
            PG_LDA(At, 1, 1); PG_STAGE(PG_SB(1, 0), b3, vb[0]); PG_STAGE(PG_SB(1, 1), b3, vb[1]); PG_STAGE(PG_SA(1, 0), a3, va[0]);
            PG_WAIT_V(8); PG_WAIT_L(0); PG_BAR; PG_MMA(1, 0, At, B0); PG_MMA(1, 1, At, B1); PG_BAR; PG_SCHED;
        }
        if (wr == 0) PG_BAR;
        E(acc, cur, wr, wc, fr, fq);
        S.done(cur);
        if (!has_next) break;
#pragma unroll
        for (int a = 0; a < 2; ++a)
#pragma unroll
            for (int b = 0; b < 2; ++b)
#pragma unroll
                for (int m = 0; m < 4; ++m)
#pragma unroll
                    for (int n = 0; n < 2; ++n) acc[a][b][m][n] = (f32x4){0.f, 0.f, 0.f, 0.f};
        cur = nxt; cA = nA; cB = nB; ++ui;
        if (wr == 1) PG_BAR;
    }
    PG_WAIT_V(0);
    PG_BAR;
#undef PG_SA
#undef PG_SB
#undef PG_STAGE
#undef PG_LDA
#undef PG_LDB
#undef PG_MMA
#undef PG_WAIT_V
#undef PG_WAIT_L
#undef PG_BAR
#undef PG_SCHED
}
#define PG_FOREACH(acc, ...) _Pragma("unroll") for (int ai = 0; ai < 2; ++ai) _Pragma("unroll") for (int m = 0; m < 4; ++m) { const int rl = ai * 128 + wr * 64 + m * 16 + fr; \
    _Pragma("unroll") for (int bj = 0; bj < 2; ++bj) { const int cl = bj * 128 + wc * 32 + fq * 8; const f32x4 v0 = acc[ai][bj][m][0], v1 = acc[ai][bj][m][1]; __VA_ARGS__ } }

__device__ __forceinline__ void store_rot(bf16* headrow  , int d0, const f32x4& t0, const f32x4& t1  , const f32x4& v0, const f32x4& v1) {
    typedef unsigned u32x2 __attribute__((ext_vector_type(2)));
    u32x2 lo, hi;
    lo.x = cvt_pk_bf16(v0[0] * t0[0] - v1[0] * t0[1], v0[1] * t0[2] - v1[1] * t0[3]); lo.y = cvt_pk_bf16(v0[2] * t1[0] - v1[2] * t1[1], v0[3] * t1[2] - v1[3] * t1[3]);
    hi.x = cvt_pk_bf16(v1[0] * t0[0] + v0[0] * t0[1], v1[1] * t0[2] + v0[1] * t0[3]); hi.y = cvt_pk_bf16(v1[2] * t1[0] + v0[2] * t1[1], v1[3] * t1[2] + v0[3] * t1[3]);
    asm volatile("s_nop 1" ::: "memory");
    const auto rx = __builtin_amdgcn_permlane16_swap(lo.x, hi.x, false, false), ry = __builtin_amdgcn_permlane16_swap(lo.y, hi.y, false, false);
    const bool oddrow = ((threadIdx.x >> 4) & 1) != 0;
    u32x4 o; o.x = rx[0]; o.y = ry[0]; o.z = rx[1]; o.w = ry[1];
    *(u32x4*)(headrow + (oddrow ? 64 + d0 - 4 : d0)) = o;
}
struct EpiProj0 {
    bf16 *qkraw, *om, *qb, *kb; const float2* rot;
    __device__ __forceinline__ void operator()(const f32x4 (&acc)[2][2][4][2], const UnitD& u, int wr, int wc, int fr, int fq) const {
        if (u.pn >= 6) {
            const int d0 = 4 * (wc * 4 + fq); bf16* dst = u.pn < 8 ? qb : kb;
#pragma unroll
            for (int ai = 0; ai < 2; ++ai)
#pragma unroll
                for (int m = 0; m < 4; ++m) { const int row = u.pm * 256 + ai * 128 + wr * 64 + m * 16 + fr, b = row >> 11, s = row & 2047;
                    const f32x4 t0 = *(const f32x4*)(rot + s * 64 + d0), t1 = *(const f32x4*)(rot + s * 64 + d0 + 2);
#pragma unroll
                    for (int bj = 0; bj < 2; ++bj) { const int h = ((u.pn & 1) << 1) + bj; store_rot(dst + ((size_t)(b * 4 + h) * 2048 + s) * 128, d0, t0, t1, acc[ai][bj][m][0], acc[ai][bj][m][1]); } }
        } else {
        PG_FOREACH(acc, { const int row = u.pm * 256 + rl;
            if (u.pn < 4) *(u32x4*)(qkraw + (size_t)row * 1024 + u.pn * 256 + cl) = pack8(v0, v1);
            else *(u32x4*)(om + (size_t)row * 512 + (u.pn - 4) * 256 + cl) = pack8(v0, v1); }) }
    }
};
struct EpiVT0 {
    bf16 *vmt, *vbt;
    __device__ __forceinline__ void operator()(const f32x4 (&acc)[2][2][4][2], const UnitD& u, int wr, int wc, int fr, int fq) const {
        PG_FOREACH(acc, { const int c = u.pm * 256 + rl, cc = c & 511, h = cc >> 7, d = cc & 127, n = u.pn * 256 + cl, b = n >> 11, s = n & 2047;
            *(u32x4*)((c >> 9 ? vbt : vmt) + ((size_t)(b * 4 + h) * 128 + d) * 2048 + s) = pack8(v0, v1); })
    }
};
struct EpiProj1 {
    bf16 *q1, *kc, *vc, *ks, *kw; const float2* rot;
    __device__ __forceinline__ void operator()(const f32x4 (&acc)[2][2][4][2], const UnitD& u, int wr, int wc, int fr, int fq) const {
        if (u.pn >= 6) {
            const int d0 = 4 * (wc * 4 + fq); bf16* dst = u.pn == 6 ? ks : kw;
#pragma unroll
            for (int ai = 0; ai < 2; ++ai)
#pragma unroll
                for (int m = 0; m < 4; ++m) { const int row = u.pm * 256 + ai * 128 + wr * 64 + m * 16 + fr, b = row >> 11, s = row & 2047;
                    const f32x4 t0 = *(const f32x4*)(rot + s * 64 + d0), t1 = *(const f32x4*)(rot + s * 64 + d0 + 2);
#pragma unroll
                    for (int bj = 0; bj < 2; ++bj) store_rot(dst + ((size_t)(b * 2 + bj) * 2048 + s) * 128, d0, t0, t1, acc[ai][bj][m][0], acc[ai][bj][m][1]); }
        } else {
        PG_FOREACH(acc, { const int row = u.pm * 256 + rl, b = row >> 11, s = row & 2047;
            if (u.pn < 4) *(u32x4*)(q1 + ((size_t)(b * 8 + u.pn * 2 + (cl >> 7)) * 2048 + s) * 128 + (cl & 127)) = pack8(v0, v1);
            else *(u32x4*)((u.pn == 4 ? kc : vc) + ((size_t)(b * 2 + (cl >> 7)) * 2048 + s) * 128 + (cl & 127)) = pack8(v0, v1); }) }
    }
};
struct EpiVT1 {
    bf16 *vst, *vwt;
    __device__ __forceinline__ void operator()(const f32x4 (&acc)[2][2][4][2], const UnitD& u, int wr, int wc, int fr, int fq) const {
        PG_FOREACH(acc, { const int c = u.pm * 256 + rl, g = (c >> 7) & 1, d = c & 127, n = u.pn * 256 + cl, b = n >> 11, s = n & 2047;
            *(u32x4*)((c >> 8 ? vwt : vst) + ((size_t)(b * 2 + g) * 128 + d) * 2048 + s) = pack8(v0, v1); })
    }
};
template <bool IN_BF16>
struct EpiOut {
    const void* hin; bf16* hout;
    __device__ __forceinline__ void operator()(const f32x4 (&acc)[2][2][4][2], const UnitD& u, int wr, int wc, int fr, int fq) const {
        PG_FOREACH(acc, { const size_t o = (size_t)(u.pm * 256 + rl) * 1024 + u.pn * 256 + cl; f32x4 x0, x1;
            if (IN_BF16) { const u32x4 t = *(const u32x4*)((const bf16*)hin + o); x0 = (f32x4){lo16(t.x), hi16(t.x), lo16(t.y), hi16(t.y)}; x1 = (f32x4){lo16(t.z), hi16(t.z), lo16(t.w), hi16(t.w)}; }
            else { x0 = *(const f32x4*)((const float*)hin + o); x1 = *(const f32x4*)((const float*)hin + o + 4); }
            *(u32x4*)(hout + o) = pack8(x0 + v0, x1 + v1); })
    }
};
constexpr int MOE_TAB_OFF = LDSCTL_OFF + 1024;
struct UnitM { int e, mt, pn, tile; };
template <int NPN>
struct MoeOrder {
    int G, vcu; const LAS int* pre;
    __device__ bool get(int i, UnitM& u) const {
        const int L = i * G + vcu, tile = L / NPN; if (tile >= __builtin_amdgcn_readfirstlane(pre[16])) return false;
        int e = 0;
#pragma unroll
        for (int q = 1; q < 16; ++q) e += (tile >= __builtin_amdgcn_readfirstlane(pre[q])) ? 1 : 0;
        u.e = e; u.mt = tile - __builtin_amdgcn_readfirstlane(pre[e]); u.pn = L % NPN; u.tile = tile; return true;
    }
};
struct MoeSched1 {
    typedef UnitM U;
    const bf16* XN; const bf16* W13T; const int* cnt; const uint2* list; MoeOrder<2> ord; unsigned* pub;
    __device__ bool next(int i, U& u) const { return ord.get(i, u); }
    __device__ void done(const U& u) const { if (pub) { asm volatile("s_waitcnt vmcnt(0) lgkmcnt(0)\n\ts_barrier" ::: "memory");
            if (threadIdx.x == 0) (void)__hip_atomic_fetch_add(pub + u.tile * 32, 1u, __ATOMIC_RELAXED, __HIP_MEMORY_SCOPE_AGENT); } }
    __device__ void uni(U& u) const { u.e = __builtin_amdgcn_readfirstlane(u.e); u.mt = __builtin_amdgcn_readfirstlane(u.mt); u.pn = __builtin_amdgcn_readfirstlane(u.pn); u.tile = __builtin_amdgcn_readfirstlane(u.tile); }
    __device__ const char* abase(const U&) const { return (const char*)XN; }
    __device__ unsigned aoff(const U& u, int r, int c) const { const int idx = u.mt * 256 + r; const int tok = idx < cnt[u.e * 32] ? (int)(list[u.e * T_ + idx].x >> 1) : 0; return (unsigned)(tok * 1024 + c) * 2u; }
    __device__ const char* bbase(const U& u) const { return (const char*)(W13T + ((size_t)u.e * 512 + u.pn * 256) * 1024); }
};
struct MoeSched2 {
    typedef UnitM U;
    const bf16* H; const bf16* W2T; MoeOrder<4> ord;
    const unsigned* sub; int ubase, ucount, busy, nfree, rot;
    __device__ bool next(int i, U& u) const {
        if (!sub) return ord.get(i, u);
        int k = ord.vcu - busy; if (k < 0) return false;
        k -= rot; if (k < 0) k += nfree;
        const int j = i * nfree + k; if (j >= ucount) return false;
        const int L = ubase + j, tile = L >> 2;
        int e = 0;
#pragma unroll
        for (int q = 1; q < 16; ++q) e += (tile >= __builtin_amdgcn_readfirstlane(ord.pre[q])) ? 1 : 0;
        u.e = e; u.mt = tile - __builtin_amdgcn_readfirstlane(ord.pre[e]); u.pn = L & 3; u.tile = tile;
        if ((threadIdx.x >> 6) == 0) { unsigned sp = 0;
            while (__hip_atomic_load(sub + tile * 32, __ATOMIC_RELAXED, __HIP_MEMORY_SCOPE_AGENT) < 2u) { __builtin_amdgcn_s_sleep(8); if (++sp > (1u << 20)) break; } }
        asm volatile("s_waitcnt vmcnt(0) lgkmcnt(0)\n\ts_barrier" ::: "memory");
        return true;
    }
    __device__ void uni(U& u) const { u.e = __builtin_amdgcn_readfirstlane(u.e); u.mt = __builtin_amdgcn_readfirstlane(u.mt); u.pn = __builtin_amdgcn_readfirstlane(u.pn); u.tile = __builtin_amdgcn_readfirstlane(u.tile); }
    __device__ const char* abase(const U& u) const { return (const char*)(H + (size_t)u.tile * 256 * 256); }
    __device__ unsigned aoff(const U&, int r, int c) const { return (unsigned)(r * 256 + c) * 2u; }
    __device__ const char* bbase(const U& u) const { return (const char*)(W2T + ((size_t)u.e * 1024 + u.pn * 256) * 256); }
    __device__ void done(const U&) const {}
};
struct EpiMoe1 {
    bf16* H; const int* cnt; const float* listr;
    __device__ __forceinline__ void operator()(const f32x4 (&acc)[2][2][4][2], const UnitM& u, int wr, int wc, int fr, int fq) const {
        const int ne = cnt[u.e * 32];
        float rs[8];
#pragma unroll
        for (int q = 0; q < 8; ++q) { const int idx = u.mt * 256 + (q >> 2) * 128 + wr * 64 + (q & 3) * 16 + fr; rs[q] = idx < ne ? listr[u.e * T_ + idx] : 0.f; }
#pragma unroll
        for (int ai = 0; ai < 2; ++ai)
#pragma unroll
            for (int m = 0; m < 4; ++m) { const int rl = ai * 128 + wr * 64 + m * 16 + fr; const float r = rs[ai * 4 + m]; f32x4 h[2];
#pragma unroll
                for (int n = 0; n < 2; ++n)
#pragma unroll
                    for (int j = 0; j < 4; ++j) { const float a = r * acc[ai][0][m][n][j], b = r * acc[ai][1][m][n][j]; h[n][j] = a * b * __builtin_amdgcn_rcpf(1.f + __expf(-a)); }
                st16_wt(H + ((size_t)u.tile * 256 + rl) * 256 + u.pn * 128 + wc * 32 + fq * 8, pack8(h[0], h[1])); }
    }
};
struct EpiMoe2 {
    const int* cnt; const uint2* liste; bf16* ys0; bf16* ys1; const bf16* hres;
    __device__ __forceinline__ void operator()(const f32x4 (&acc)[2][2][4][2], const UnitM& u, int wr, int wc, int fr, int fq) const {
        const int ne = cnt[u.e * 32];
        int ent[8]; float w[8];
#pragma unroll
        for (int q = 0; q < 8; ++q) { const int idx = u.mt * 256 + (q >> 2) * 128 + wr * 64 + (q & 3) * 16 + fr; const bool ok = idx < ne;
            uint2 t_ = make_uint2(0xffffffffu, 0u); if (ok) t_ = liste[u.e * T_ + idx]; ent[q] = (int)t_.x; w[q] = __uint_as_float(t_.y); }
        const unsigned colo = (unsigned)(u.pn * 256 + wc * 32 + fq * 8);
#pragma unroll
        for (int hf = 0; hf < 2; ++hf) {
            u32x4 hr[4][2];
#pragma unroll
            for (int qq = 0; qq < 4; ++qq) { const int q = hf * 4 + qq; const bool s0 = ent[q] >= 0 && !(ent[q] & 1);
#pragma unroll
                for (int bj = 0; bj < 2; ++bj) hr[qq][bj] = s0 ? *(const u32x4*)(hres + (unsigned)((ent[q] >> 1) * 1024) + colo + bj * 128) : (u32x4){0u, 0u, 0u, 0u}; }
#pragma unroll
            for (int qq = 0; qq < 4; ++qq) { const int q = hf * 4 + qq, ai = q >> 2, m = q & 3;
                if (ent[q] >= 0) { const unsigned off = (unsigned)(((ent[q] & 1) * T_ + (ent[q] >> 1)) * 1024) + colo;
#pragma unroll
                    for (int bj = 0; bj < 2; ++bj) { const u32x4 t = hr[qq][bj];
                        const f32x4 r0 = {lo16(t.x), hi16(t.x), lo16(t.y), hi16(t.y)}, r1 = {lo16(t.z), hi16(t.z), lo16(t.w), hi16(t.w)};
                        *(u32x4*)(ys0 + off + bj * 128) = pack8(acc[ai][bj][m][0] * w[q] + r0, acc[ai][bj][m][1] * w[q] + r1); } } }
            asm volatile("" ::: "memory"); }
    }
};
struct UnitC { int kv, pm, ks; };
struct CmpSched {
    typedef UnitC U;
    const bf16* KC; const bf16* VC; const bf16* WK; const bf16* WV; int G, c;
    __device__ bool next(int i, U& u) const { const int L = i * G + c; if (L >= 64) return false; u.kv = L >> 5; u.pm = (L >> 2) & 7; u.ks = L & 3; return true; }
    __device__ void uni(U& u) const { u.kv = __builtin_amdgcn_readfirstlane(u.kv); u.pm = __builtin_amdgcn_readfirstlane(u.pm); u.ks = __builtin_amdgcn_readfirstlane(u.ks); }
    __device__ const char* abase(const U& u) const { return (const char*)((u.kv ? VC : KC) + (size_t)u.pm * 256 * 2048 + u.ks * 1024); }
    __device__ unsigned aoff(const U&, int r, int c) const { return (unsigned)(r * 2048 + c) * 2u; }
    __device__ const char* bbase(const U& u) const { return (const char*)((u.kv ? WV : WK) + u.ks * 1024); }
    __device__ void done(const U&) const {}
};
struct EpiCmp1 {
    bf16* part;
    __device__ __forceinline__ void operator()(const f32x4 (&acc)[2][2][4][2], const UnitC& u, int wr, int wc, int fr, int fq) const {
        bf16* base = part + ((size_t)(u.ks * 2 + u.kv) * 2048 + u.pm * 256) * 256;
        PG_FOREACH(acc, { *(u32x4*)(base + (size_t)rl * 256 + cl) = pack8(v0, v1); })
    }
};
}

namespace at {
typedef short bf16x8 __attribute__((ext_vector_type(8)));
typedef short s16x4 __attribute__((ext_vector_type(4)));
typedef float f32x16 __attribute__((ext_vector_type(16)));
typedef unsigned u32x4 __attribute__((ext_vector_type(4)));
typedef unsigned u32x2 __attribute__((ext_vector_type(2)));
#define DI __device__ __forceinline__
#define AT_MFMA(a, b, c) __builtin_amdgcn_mfma_f32_32x32x16_bf16((a), (b), (c), 0, 0, 0)
constexpr int KPITCH = 272, VPITCH = 136, KBYTES = 64 * KPITCH, VBYTES = 128 * VPITCH, GOFF = KBYTES + VBYTES, BUFB = GOFF + 256;
constexpr int XOFF = 2 * BUFB;
constexpr float SC2 = 0.08838834764831845f * 1.4426950408889634f;
constexpr float LOG2E = 1.4426950408889634f;

DI float vmax3(float a, float b, float c) { float r; asm("v_max3_f32 %0, %1, %2, %3" : "=v"(r) : "v"(a), "v"(b), "v"(c)); return r; }
DI bf16x8 pack_step(const f32x16& x, int s) {
    u32x4 p;
    asm volatile("s_nop 0\n\tv_cvt_pk_bf16_f32 %0, %4, %5\n\tv_cvt_pk_bf16_f32 %1, %6, %7\n\tv_cvt_pk_bf16_f32 %2, %8, %9\n\tv_cvt_pk_bf16_f32 %3, %10, %11\n\ts_nop 1"
                 : "=&v"(p[0]), "=&v"(p[1]), "=&v"(p[2]), "=&v"(p[3])
                 : "v"(x[8 * s]), "v"(x[8 * s + 1]), "v"(x[8 * s + 2]), "v"(x[8 * s + 3]), "v"(x[8 * s + 4]), "v"(x[8 * s + 5]), "v"(x[8 * s + 6]), "v"(x[8 * s + 7]));
    return __builtin_bit_cast(bf16x8, p);
}
DI void zero4(f32x16 (&o)[4]) {
#pragma unroll
    for (int d = 0; d < 4; ++d)
#pragma unroll
        for (int i = 0; i < 16; ++i) o[d][i] = 0.f; }
DI void load_q(bf16x8 (&q)[8], const bf16* qrows  , int c, int h) {
#pragma unroll
    for (int ks = 0; ks < 8; ++ks) q[ks] = *(const bf16x8*)(qrows + c * 128 + 16 * ks + 8 * h); }
DI void rot_q(bf16x8 (&q)[8], const float2* rot, int pos, int h) {
#pragma unroll
    for (int ks = 0; ks < 4; ++ks) { u32x4 lo, hi; const u32x4 a = __builtin_bit_cast(u32x4, q[ks]), b = __builtin_bit_cast(u32x4, q[ks + 4]);
#pragma unroll
        for (int jj = 0; jj < 4; ++jj) { const float4 t = *(const float4*)(rot + pos * 64 + 16 * ks + 8 * h + 2 * jj);
            const float x0 = lo16(a[jj]), x1 = hi16(a[jj]), y0 = lo16(b[jj]), y1 = hi16(b[jj]);
            lo[jj] = pk2(x0 * t.x - y0 * t.y, x1 * t.z - y1 * t.w); hi[jj] = pk2(y0 * t.x + x0 * t.y, y1 * t.z + x1 * t.w); }
        q[ks] = __builtin_bit_cast(bf16x8, lo); q[ks + 4] = __builtin_bit_cast(bf16x8, hi); }
}
struct Stage { u32x4 k[2]; u32x4 v[2]; float g; };
DI void stage_load(Stage& s, const bf16* kt, const bf16* vt, int vpitch, const float* li, const float* bc, int tid) {
#pragma unroll
    for (int p = 0; p < 2; ++p) { const int idx = p * 512 + tid; s.k[p] = *(const u32x4*)(kt + idx * 8); s.v[p] = *(const u32x4*)(vt + (size_t)(idx >> 3) * vpitch + (idx & 7) * 8); }
    s.g = 0.f; if (li && tid < 64) s.g = (li[tid] - bc[tid]) * LOG2E;
}
DI void stage_write(const Stage& s, LAS unsigned char* buf, bool hasg, int tid) {
#pragma unroll
    for (int p = 0; p < 2; ++p) { const int idx = p * 512 + tid;
        *(LAS u32x4*)(buf + (idx >> 4) * KPITCH + (idx & 15) * 16) = s.k[p];
        LAS unsigned char* d = buf + KBYTES + (idx >> 3) * VPITCH + (idx & 7) * 16;
        u32x2 lo; lo.x = s.v[p].x; lo.y = s.v[p].y; u32x2 hi; hi.x = s.v[p].z; hi.y = s.v[p].w;
        *(LAS u32x2*)d = lo; *(LAS u32x2*)(d + 8) = hi; }
    if (hasg && tid < 64) *(LAS float*)(buf + GOFF + tid * 4) = s.g;
}
DI void s_tile(f32x16 (&st)[2], const bf16x8 (&q)[8], const LAS unsigned char* kbuf, int r, int h) {
    bf16x8 a[2][8];
#pragma unroll
    for (int t = 0; t < 2; ++t)
#pragma unroll
        for (int ks = 0; ks < 8; ++ks) a[t][ks] = *(const LAS bf16x8*)(kbuf + (32 * t + r) * KPITCH + (16 * ks + 8 * h) * 2);
#pragma unroll
    for (int t = 0; t < 2; ++t) { f32x16 acc;
#pragma unroll
        for (int i = 0; i < 16; ++i) acc[i] = 0.f;
#pragma unroll
        for (int ks = 0; ks < 8; ++ks) acc = AT_MFMA(a[t][ks], q[ks], acc);
        st[t] = acc; }
}
DI void s_tile_asm(f32x16 (&st)[2], const bf16x8 (&q)[8], const LAS unsigned char* kbuf, int r, int h) {
    static_assert(KPITCH == 272, "offsets below assume the 272-byte K pitch");
    const unsigned a = (unsigned)(size_t)(kbuf + r * KPITCH + 16 * h);
    bf16x8 f0, f1, f2, f3, f4, f5, f6, f7; f32x16 c0, c1;
    asm volatile(
        "ds_read_b128 %[f0], %[a] offset:0\n\t"
        "ds_read_b128 %[f1], %[a] offset:32\n\t"
        "ds_read_b128 %[f2], %[a] offset:64\n\t"
        "ds_read_b128 %[f3], %[a] offset:96\n\t"
        "ds_read_b128 %[f4], %[a] offset:128\n\t"
        "ds_read_b128 %[f5], %[a] offset:160\n\t"
        "ds_read_b128 %[f6], %[a] offset:192\n\t"
        "ds_read_b128 %[f7], %[a] offset:224\n\t"
        "s_waitcnt lgkmcnt(7)\n\t"
        "v_mfma_f32_32x32x16_bf16 %[c0], %[f0], %[q0], 0\n\t"
        "ds_read_b128 %[f0], %[a] offset:8704\n\t"
        "s_waitcnt lgkmcnt(7)\n\t"
        "v_mfma_f32_32x32x16_bf16 %[c0], %[f1], %[q1], %[c0]\n\t"
        "ds_read_b128 %[f1], %[a] offset:8736\n\t"
        "s_waitcnt lgkmcnt(7)\n\t"
        "v_mfma_f32_32x32x16_bf16 %[c0], %[f2], %[q2], %[c0]\n\t"
        "ds_read_b128 %[f2], %[a] offset:8768\n\t"
        "s_waitcnt lgkmcnt(7)\n\t"
        "v_mfma_f32_32x32x16_bf16 %[c0], %[f3], %[q3], %[c0]\n\t"
        "ds_read_b128 %[f3], %[a] offset:8800\n\t"
        "s_waitcnt lgkmcnt(7)\n\t"
        "v_mfma_f32_32x32x16_bf16 %[c0], %[f4], %[q4], %[c0]\n\t"
        "ds_read_b128 %[f4], %[a] offset:8832\n\t"
        "s_waitcnt lgkmcnt(7)\n\t"
        "v_mfma_f32_32x32x16_bf16 %[c0], %[f5], %[q5], %[c0]\n\t"
        "ds_read_b128 %[f5], %[a] offset:8864\n\t"
        "s_waitcnt lgkmcnt(7)\n\t"
        "v_mfma_f32_32x32x16_bf16 %[c0], %[f6], %[q6], %[c0]\n\t"
        "ds_read_b128 %[f6], %[a] offset:8896\n\t"
        "s_waitcnt lgkmcnt(7)\n\t"
        "v_mfma_f32_32x32x16_bf16 %[c0], %[f7], %[q7], %[c0]\n\t"
        "ds_read_b128 %[f7], %[a] offset:8928\n\t"
        "s_waitcnt lgkmcnt(7)\n\t"
        "v_mfma_f32_32x32x16_bf16 %[c1], %[f0], %[q0], 0\n\t"
        "s_waitcnt lgkmcnt(6)\n\t"
        "v_mfma_f32_32x32x16_bf16 %[c1], %[f1], %[q1], %[c1]\n\t"
        "s_waitcnt lgkmcnt(5)\n\t"
        "v_mfma_f32_32x32x16_bf16 %[c1], %[f2], %[q2], %[c1]\n\t"
        "s_waitcnt lgkmcnt(4)\n\t"
        "v_mfma_f32_32x32x16_bf16 %[c1], %[f3], %[q3], %[c1]\n\t"
        "s_waitcnt lgkmcnt(3)\n\t"
        "v_mfma_f32_32x32x16_bf16 %[c1], %[f4], %[q4], %[c1]\n\t"
        "s_waitcnt lgkmcnt(2)\n\t"
        "v_mfma_f32_32x32x16_bf16 %[c1], %[f5], %[q5], %[c1]\n\t"
        "s_waitcnt lgkmcnt(1)\n\t"
        "v_mfma_f32_32x32x16_bf16 %[c1], %[f6], %[q6], %[c1]\n\t"
        "s_waitcnt lgkmcnt(0)\n\t"
        "v_mfma_f32_32x32x16_bf16 %[c1], %[f7], %[q7], %[c1]\n\t"
        "s_nop 15\n\t"
        "s_nop 7"
        : [c0] "=&v"(c0), [c1] "=&v"(c1), [f0] "=&v"(f0), [f1] "=&v"(f1), [f2] "=&v"(f2), [f3] "=&v"(f3), [f4] "=&v"(f4), [f5] "=&v"(f5), [f6] "=&v"(f6), [f7] "=&v"(f7)
        : [a] "v"(a), [q0] "v"(q[0]), [q1] "v"(q[1]), [q2] "v"(q[2]), [q3] "v"(q[3]), [q4] "v"(q[4]), [q5] "v"(q[5]), [q6] "v"(q[6]), [q7] "v"(q[7])
        : "memory");
    st[0] = c0; st[1] = c1;
}
DI void s_tile_h(f32x16 (&st)[2], const bf16x8 (&q)[8], const LAS unsigned char* kbuf, int r, int h) {
#pragma unroll
    for (int t = 0; t < 2; ++t) { bf16x8 a[8];
#pragma unroll
        for (int ks = 0; ks < 8; ++ks) a[ks] = *(const LAS bf16x8*)(kbuf + (32 * t + r) * KPITCH + (16 * ks + 8 * h) * 2);
        f32x16 acc;
#pragma unroll
        for (int i = 0; i < 16; ++i) acc[i] = 0.f;
#pragma unroll
        for (int ks = 0; ks < 8; ++ks) acc = AT_MFMA(a[ks], q[ks], acc);
        st[t] = acc; asm volatile("" ::: "memory"); }
}
DI void pv_frags(s16x4 (&f)[8], const LAS unsigned char* vbuf, int t, int s, int r, int h) {
#pragma unroll
    for (int dt = 0; dt < 4; ++dt) { const LAS unsigned char* a = vbuf + (32 * dt + r) * VPITCH + (32 * t + 16 * s + 4 * h) * 2; f[2 * dt] = *(const LAS s16x4*)a; f[2 * dt + 1] = *(const LAS s16x4*)(a + 16); }
}
DI void pv_tile(f32x16 (&ot)[4], const f32x16 (&p)[2], const LAS unsigned char* vbuf, int r, int h) {
    s16x4 fa[8], fb[8];
    pv_frags(fa, vbuf, 0, 0, r, h);
#pragma unroll
    for (int step = 0; step < 4; ++step) { const int t = step >> 1, s = step & 1;
        if (step < 3) { if (step & 1) pv_frags(fa, vbuf, (step + 1) >> 1, (step + 1) & 1, r, h); else pv_frags(fb, vbuf, (step + 1) >> 1, (step + 1) & 1, r, h); }
        const bf16x8 pb = pack_step(p[t], s);
#pragma unroll
        for (int dt = 0; dt < 4; ++dt) { const s16x4 lo = (step & 1) ? fb[2 * dt] : fa[2 * dt], hi = (step & 1) ? fb[2 * dt + 1] : fa[2 * dt + 1];
            ot[dt] = AT_MFMA(__builtin_shufflevector(lo, hi, 0, 1, 2, 3, 4, 5, 6, 7), pb, ot[dt]); } }
}
#define AT_KL(t, i) (32 * (t) + ((i) & 3) + 8 * ((i) >> 2) + 4 * h)
#define AT_SOFTMAX(st, ot, m, l, VALID) do { float tm_ = -1e30f; \
    _Pragma("unroll") for (int t = 0; t < 2; ++t) _Pragma("unroll") for (int i = 0; i < 16; ++i) { const int kl = AT_KL(t, i); if (VALID) tm_ = fmaxf(tm_, st[t][i]); } \
    tm_ = fmaxf(tm_, __shfl_xor(tm_, 32)); \
    const float mn_ = fmaxf(m, tm_ * at::SC2), al_ = __builtin_amdgcn_exp2f(m - mn_); m = mn_; l *= al_; \
    if (!__all(al_ == 1.f)) { _Pragma("unroll") for (int d = 0; d < 4; ++d) _Pragma("unroll") for (int i = 0; i < 16; ++i) ot[d][i] *= al_; } \
    _Pragma("unroll") for (int t = 0; t < 2; ++t) _Pragma("unroll") for (int i = 0; i < 16; ++i) { const int kl = AT_KL(t, i); \
        const float p_ = (VALID) ? __builtin_amdgcn_exp2f(st[t][i] * at::SC2 - mn_) : 0.f; st[t][i] = p_; l += p_; } } while (0)
#define AT_SOFTMAX2(st, ot, m, l, MINE, INTERIOR, VALIDPOS) do { \
    if (!(INTERIOR)) { _Pragma("unroll") for (int t = 0; t < 2; ++t) _Pragma("unroll") for (int i = 0; i < 16; ++i) { const int kl = AT_KL(t, i); st[t][i] = (VALIDPOS) ? st[t][i] : -1e30f; } } \
    float tm_ = at::vmax3(st[0][0], st[0][1], st[1][0]); tm_ = at::vmax3(tm_, st[1][1], st[0][2]); tm_ = at::vmax3(tm_, st[0][3], st[1][2]); \
    _Pragma("unroll") for (int i = 4; i < 16; i += 2) { tm_ = at::vmax3(tm_, st[0][i], st[0][i + 1]); tm_ = at::vmax3(tm_, st[1][i - 1], st[1][i]); } \
    tm_ = at::vmax3(tm_, st[1][15], st[1][15]); { const auto r_ = __builtin_amdgcn_permlane32_swap(__float_as_uint(tm_), __float_as_uint(tm_), false, false); tm_ = at::vmax3(__uint_as_float(r_[0]), __uint_as_float(r_[1]), tm_); } \
    const bool mine_ = (MINE) && (tm_ > -1e29f); const float ts_ = tm_ * at::SC2; \
      \
    const float mn_ = (mine_ && ts_ > m + 8.f) ? ts_ : m, al_ = __builtin_amdgcn_exp2f(m - mn_); m = mn_; l *= al_; \
    if (!__all(al_ == 1.f)) { _Pragma("unroll") for (int d = 0; d < 4; ++d) ot[d] *= al_; } \
    const float mb_ = mine_ ? -mn_ : -1e30f; float l2_ = 0.f; \
    _Pragma("unroll") for (int i = 0; i < 16; ++i) { const float p0_ = __builtin_amdgcn_exp2f(__builtin_fmaf(st[0][i], at::SC2, mb_)), p1_ = __builtin_amdgcn_exp2f(__builtin_fmaf(st[1][i], at::SC2, mb_)); st[0][i] = p0_; st[1][i] = p1_; l += p0_; l2_ += p1_; } \
    l += l2_; } while (0)
DI void store_pair16(bf16* p, u32x2 a  , u32x2 b  , int h) {
    const auto r0 = __builtin_amdgcn_permlane32_swap(a.x, b.x, false, false), r1 = __builtin_amdgcn_permlane32_swap(a.y, b.y, false, false);
    u32x4 o; o.x = r0[0]; o.y = r1[0]; o.z = r0[1]; o.w = r1[1];
    *(u32x4*)(p + 8 * h) = o;
}
DI void store_ot(const f32x16 (&ot)[4], float scale, bf16* yrow  , int h) {
#pragma unroll
    for (int dt = 0; dt < 4; ++dt)
#pragma unroll
        for (int g = 0; g < 4; g += 2) { u32x2 w[2];
#pragma unroll
            for (int k = 0; k < 2; ++k) { w[k].x = pk2(ot[dt][4 * (g + k)] * scale, ot[dt][4 * (g + k) + 1] * scale); w[k].y = pk2(ot[dt][4 * (g + k) + 2] * scale, ot[dt][4 * (g + k) + 3] * scale); }
            store_pair16(yrow + 32 * dt + 8 * g, w[0], w[1], h); }
}

DI void ypk_set(u32x2 (&y)[4][4], const f32x16 (&ot)[4], float sc) {
#pragma unroll
    for (int dt = 0; dt < 4; ++dt)
#pragma unroll
        for (int g = 0; g < 4; ++g) { y[dt][g].x = pk2(ot[dt][4 * g] * sc, ot[dt][4 * g + 1] * sc); y[dt][g].y = pk2(ot[dt][4 * g + 2] * sc, ot[dt][4 * g + 3] * sc); } }
DI void ypk_add(u32x2 (&y)[4][4], const f32x16 (&ot)[4], float sc) {
#pragma unroll
    for (int dt = 0; dt < 4; ++dt)
#pragma unroll
        for (int g = 0; g < 4; ++g) { const u32x2 o = y[dt][g];
            y[dt][g].x = pk2(lo16(o.x) + ot[dt][4 * g] * sc, hi16(o.x) + ot[dt][4 * g + 1] * sc); y[dt][g].y = pk2(lo16(o.y) + ot[dt][4 * g + 2] * sc, hi16(o.y) + ot[dt][4 * g + 3] * sc); } }
DI void ypk_store(const u32x2 (&y)[4][4], bf16* yrow, int h) {
#pragma unroll
    for (int dt = 0; dt < 4; ++dt)
#pragma unroll
        for (int g = 0; g < 4; ++g) *(u32x2*)(yrow + 32 * dt + 8 * g + 4 * h) = y[dt][g]; }
DI void accum_ot(const f32x16 (&ot)[4], float scale, bf16* yrow, int h) {
#pragma unroll
    for (int dt = 0; dt < 4; ++dt)
#pragma unroll
        for (int g = 0; g < 4; ++g) { bf16* p = yrow + 32 * dt + 8 * g + 4 * h; const u32x2 o = *(const u32x2*)p;
            u32x2 w; w.x = pk2(lo16(o.x) + ot[dt][4 * g] * scale, hi16(o.x) + ot[dt][4 * g + 1] * scale); w.y = pk2(lo16(o.y) + ot[dt][4 * g + 2] * scale, hi16(o.y) + ot[dt][4 * g + 3] * scale);
            *(u32x2*)p = w; }
}

DI void mlstm_unit(int bh, int qb, LAS unsigned char* lds, const bf16* QM, const bf16* KM, const bf16* VMT, const float* LI, const float* BC, const bf16* OM, const float* gain, bf16* Y0) {
    int tid = threadIdx.x; asm volatile("" : "+v"(tid));
    const int w = __builtin_amdgcn_readfirstlane(tid >> 6), lane = tid & 63, c = lane & 31, h = lane >> 5, r = c;
    const int q0 = qb * 256 + w * 32, q = q0 + c;
    bf16x8 qf[8]; load_q(qf, QM + ((size_t)bh * 2048 + q0) * 128, c, h);
    const float bq2 = BC[bh * 2048 + q] * LOG2E - 3.5f;
    f32x16 ot[4]; zero4(ot); float den = 0.f;
    const bf16* kbase = KM + (size_t)bh * 2048 * 128; const bf16* vbase = VMT + (size_t)bh * 128 * 2048;
    const float* li = LI + bh * 2048; const float* bc = BC + bh * 2048;
    const int ntiles = 4 * qb + 4;
    Stage sg; stage_load(sg, kbase, vbase, 2048, li, bc, tid); stage_write(sg, lds, true, tid);
    if (ntiles > 1) stage_load(sg, kbase + (size_t)64 * 128, vbase + 64, 2048, li + 64, bc + 64, tid);
    __syncthreads();
    for (int i = 0; i < ntiles; ++i) {
        LAS unsigned char* buf = lds + (i & 1) * BUFB;
        if (i + 1 < ntiles) stage_write(sg, lds + ((i + 1) & 1) * BUFB, true, tid);
        if (i + 2 < ntiles) stage_load(sg, kbase + (size_t)(i + 2) * 64 * 128, vbase + (i + 2) * 64, 2048, li + (i + 2) * 64, bc + (i + 2) * 64, tid);
        if (i * 64 <= q0 + 31) {
            f32x16 st[2]; s_tile_asm(st, qf, buf, r, h);
            typedef float f4v __attribute__((ext_vector_type(4)));
            const LAS float* gk = (const LAS float*)(buf + GOFF);
            const bool interior = i * 64 + 63 <= q0;
            float den2 = 0.f;
#pragma unroll
            for (int t = 0; t < 2; ++t) { f4v gv[4];
#pragma unroll
                for (int g = 0; g < 4; ++g) gv[g] = *(const LAS f4v*)(gk + 32 * t + 8 * g + 4 * h);
                if (interior) {
#pragma unroll
                    for (int e = 0; e < 16; e += 2) { const float p0 = st[t][e] * __builtin_amdgcn_exp2f(bq2 + gv[e >> 2][e & 3]), p1 = st[t][e + 1] * __builtin_amdgcn_exp2f(bq2 + gv[e >> 2][(e & 3) + 1]);
                        st[t][e] = p0; st[t][e + 1] = p1; den += p0; den2 += p1; }
                } else {
#pragma unroll
                    for (int e = 0; e < 16; ++e) { const int kl = AT_KL(t, e); const float pv = st[t][e] * __builtin_amdgcn_exp2f(bq2 + gv[e >> 2][e & 3]);
                        const float p = (i * 64 + kl <= q) ? pv : 0.f; st[t][e] = p; den += p; }
                } }
            den += den2;
            pv_tile(ot, st, buf + KBYTES, r, h);
        }
        __syncthreads();
    }
    den += __shfl_xor(den, 32);
    const float inv = 1.f / fmaxf(fabsf(den), 1.f);
    float ss = 0.f;
#pragma unroll
    for (int d = 0; d < 4; ++d)
#pragma unroll
        for (int e = 0; e < 16; ++e) { ot[d][e] *= inv; ss += ot[d][e] * ot[d][e]; }
    ss += __shfl_xor(ss, 32);
    const float rn = rsqrtf(ss * (1.f / 128.f) + 1e-6f);
    const int b = bh >> 2, hh = bh & 3; const size_t m = (size_t)b * 2048 + q;
#pragma unroll
    for (int dt = 0; dt < 4; ++dt)
#pragma unroll
        for (int g2 = 0; g2 < 4; g2 += 2) { u32x2 wv[2];
#pragma unroll
            for (int k = 0; k < 2; ++k) { const int g = g2 + k, d0 = 32 * dt + 8 * g + 4 * h, col = hh * 128 + d0;
                const float4 gg = *(const float4*)(gain + col); const uint2 oo = *(const uint2*)(OM + m * 512 + col);
                const float y0 = ot[dt][4 * g] * rn * gg.x * sigmoidf_(lo16(oo.x)), y1 = ot[dt][4 * g + 1] * rn * gg.y * sigmoidf_(hi16(oo.x));
                const float y2 = ot[dt][4 * g + 2] * rn * gg.z * sigmoidf_(lo16(oo.y)), y3 = ot[dt][4 * g + 3] * rn * gg.w * sigmoidf_(hi16(oo.y));
                wv[k].x = pk2(y0, y1); wv[k].y = pk2(y2, y3); }
            store_pair16(Y0 + m * 1024 + hh * 128 + 32 * dt + 8 * g2, wv[0], wv[1], h); }
}

DI void moba_unit(int bh, int cur, LAS unsigned char* lds, const bf16* QB, const bf16* KB, const bf16* VBT, const float* KMEAN, bf16* Y0) {
    int tid = threadIdx.x; asm volatile("" : "+v"(tid));
    const int w = __builtin_amdgcn_readfirstlane(tid >> 6), lane = tid & 63, c = lane & 31, h = lane >> 5, r = c;
    const int q0 = cur * 256 + w * 32, q = q0 + c;
    bf16x8 qf[8]; load_q(qf, QB + ((size_t)bh * 2048 + q0) * 128, c, h);
    LAS float* km = (LAS float*)(lds + XOFF); LAS unsigned* uni = (LAS unsigned*)(lds + XOFF + 4096);
    for (int i = tid; i < 1024; i += 512) km[i] = KMEAN[bh * 1024 + i];
    if (tid == 0) uni[0] = 0u;
    __syncthreads();
    float gv[7];
#pragma unroll
    for (int j = 0; j < 7; ++j) gv[j] = 0.f;
#pragma unroll
    for (int ks = 0; ks < 8; ++ks) { float qv[8];
#pragma unroll
        for (int e = 0; e < 8; ++e) qv[e] = bf2f((bf16)qf[ks][e]);
#pragma unroll
        for (int j = 0; j < 7; ++j) { if (j < cur) { const LAS float* kp = km + j * 128 + 16 * ks + 8 * h;
#pragma unroll
                for (int e = 0; e < 8; ++e) gv[j] += qv[e] * kp[e]; } } }
    unsigned sel = 0u;
#pragma unroll
    for (int j = 0; j < 7; ++j) { gv[j] += __shfl_xor(gv[j], 32); if (j >= cur) gv[j] = NEGINF; }
#pragma unroll
    for (int rnd = 0; rnd < 3; ++rnd) { float best = -3e38f; int bi = 0;
#pragma unroll
        for (int j = 0; j < 7; ++j) { const bool tk = !((sel >> j) & 1u) && gv[j] > best; best = tk ? gv[j] : best; bi = tk ? j : bi; }
        if (best > 0.5f * NEGINF) sel |= 1u << bi; }
    {   unsigned u = sel;
#pragma unroll
        for (int o = 32; o > 0; o >>= 1) u |= __shfl_xor(u, o);
        if (lane == 0) atomicOr((unsigned*)uni, u); }
    __syncthreads();
    const unsigned need = uni[0] | (1u << cur);
    f32x16 ot[4]; zero4(ot); float m = -1e30f, l = 0.f;
    const bf16* kbase = KB + (size_t)bh * 2048 * 128; const bf16* vbase = VBT + (size_t)bh * 128 * 2048;
    int tcur = 4 * (__ffs(need) - 1); unsigned rem = need;
#define MOBA_NEXT(t) { int n_ = (t) + 1; if ((n_ & 3) == 0) { rem &= rem - 1; n_ = rem ? 4 * (__ffs(rem) - 1) : -1; } (t) = n_; }
    Stage sg; stage_load(sg, kbase + (size_t)tcur * 64 * 128, vbase + tcur * 64, 2048, nullptr, nullptr, tid); stage_write(sg, lds, false, tid);
    int tn = tcur; MOBA_NEXT(tn)
    if (tn >= 0) stage_load(sg, kbase + (size_t)tn * 64 * 128, vbase + tn * 64, 2048, nullptr, nullptr, tid);
    __syncthreads();
    int bsel = 0;
    while (tcur >= 0) {
        int tn2 = tn; if (tn2 >= 0) MOBA_NEXT(tn2)
        LAS unsigned char* buf = lds + bsel * BUFB;
        if (tn >= 0) stage_write(sg, lds + (bsel ^ 1) * BUFB, false, tid);
        if (tn2 >= 0) stage_load(sg, kbase + (size_t)tn2 * 64 * 128, vbase + tn2 * 64, 2048, nullptr, nullptr, tid);
        const int blk = tcur >> 2; const bool own = blk == cur;
        const bool mine = own ? true : (((sel >> blk) & 1u) != 0u);
        const bool wave_needs = own ? (tcur * 64 <= q0 + 31) : (__ballot(mine) != 0ull);
        if (wave_needs) {
            f32x16 st[2]; s_tile_asm(st, qf, buf, r, h);
            const int k0 = tcur * 64;
            AT_SOFTMAX2(st, ot, m, l, mine, (k0 + 63 <= q0), (k0 + kl <= q));
            pv_tile(ot, st, buf + KBYTES, r, h);
        }
        __syncthreads();
        tcur = tn; tn = tn2; bsel ^= 1;
    }
#undef MOBA_NEXT
    l += __shfl_xor(l, 32);
    const float inv = 1.f / fmaxf(l, 1e-30f);
    const int b = bh >> 2, hh = bh & 3; const size_t mrow = (size_t)b * 2048 + q;
    store_ot(ot, inv, Y0 + mrow * 1024 + 512 + hh * 128, h);
}

DI void nsa_unit(int bg, int qt, LAS unsigned char* lds, const bf16* Q1, const float2* ROT, const bf16* KCMP, const bf16* VCMPT, const bf16* KS, const bf16* VST, const bf16* KW, const bf16* VWT, const float* G, bf16* Y1) {
    int tid = threadIdx.x; asm volatile("" : "+v"(tid));
    const int w = __builtin_amdgcn_readfirstlane(tid >> 6), lane = tid & 63, c = lane & 31, h = lane >> 5, r = c;
    const int b = bg >> 1, hd = (bg & 1) * 4 + (w >> 1), qi = 32 * (w & 1) + c, s = qt * 64 + qi;
    const size_t qrow0 = ((size_t)(b * 8 + hd) * 2048 + qt * 64 + 32 * (w & 1)) * 128;
    const size_t mrow = (size_t)b * 2048 + s;
    LAS float* imp = (LAS float*)(lds + XOFF);
    LAS unsigned* msk = (LAS unsigned*)(lds + XOFF + 67584);
    LAS unsigned char* ylds = lds + XOFF + ((w * 32 + c) * 264) + 8 * h;
    if (tid == 0) msk[64] = 0u;
    f32x16 ot[4];
    bf16x8 qf[8];
    LAS float* gpark = (LAS float*)(lds + XOFF + 67584 + 512) + tid;
    const unsigned goff = ((unsigned)(b * 2048 + s) * 24u + (unsigned)hd * 3u) * 4u;
    const float g0 = *(const float*)((const char*)G + goff);
    {   load_q(qf, Q1 + qrow0, c, h);
        Stage sa, sb;
        stage_load(sa, KCMP + (size_t)bg * 128 * 128, VCMPT + (size_t)bg * 128 * 128, 128, nullptr, nullptr, tid);
        stage_load(sb, KCMP + (size_t)bg * 128 * 128 + 64 * 128, VCMPT + (size_t)bg * 128 * 128 + 64, 128, nullptr, nullptr, tid);
        stage_write(sa, lds, false, tid); stage_write(sb, lds + BUFB, false, tid);
        __syncthreads();
        f32x16 sA[2], sB[2]; s_tile_asm(sA, qf, lds, r, h); s_tile_asm(sB, qf, lds + BUFB, r, h);
        float mx = -1e30f;
#pragma unroll
        for (int t = 0; t < 2; ++t)
#pragma unroll
            for (int e = 0; e < 16; ++e) { const int n0 = AT_KL(t, e), n1 = 64 + n0; if (16 * n0 + 31 <= s) mx = fmaxf(mx, sA[t][e]); if (n1 < 127 && 16 * n1 + 31 <= s) mx = fmaxf(mx, sB[t][e]); }
        mx = fmaxf(mx, __shfl_xor(mx, 32)) * SC2;
        float l = 0.f;
#pragma unroll
        for (int t = 0; t < 2; ++t)
#pragma unroll
            for (int e = 0; e < 16; ++e) { const int n0 = AT_KL(t, e), n1 = 64 + n0;
                const float pa = (16 * n0 + 31 <= s) ? __builtin_amdgcn_exp2f(sA[t][e] * SC2 - mx) : 0.f, pb = (n1 < 127 && 16 * n1 + 31 <= s) ? __builtin_amdgcn_exp2f(sB[t][e] * SC2 - mx) : 0.f;
                sA[t][e] = pa; sB[t][e] = pb; l += pa + pb; }
        l += __shfl_xor(l, 32);
        const float inv = 1.f / fmaxf(l, 1e-30f);
#pragma unroll
        for (int t = 0; t < 2; ++t)
#pragma unroll
            for (int e = 0; e < 16; ++e) { sA[t][e] *= inv; sB[t][e] *= inv; }
        {   LAS float* slab = imp + (w * 32 + c) * 32;
            float pA[2][4], pB[2][4];
#pragma unroll
            for (int t = 0; t < 2; ++t)
#pragma unroll
                for (int g = 0; g < 4; ++g) { pA[t][g] = __shfl_xor(sA[t][4 * g + 3], 32); pB[t][g] = __shfl_xor(sB[t][4 * g + 3], 32); }
#pragma unroll
            for (int t = 0; t < 2; ++t)
#pragma unroll
                for (int g = 0; g < 4; ++g) {
                    const float ra = (sA[t][4 * g] + sA[t][4 * g + 1]) + (sA[t][4 * g + 2] + sA[t][4 * g + 3]), rb = (sB[t][4 * g] + sB[t][4 * g + 1]) + (sB[t][4 * g + 2] + sB[t][4 * g + 3]);
                    const float prevA0 = g > 0 ? pA[t][g > 0 ? g - 1 : 0] : (t > 0 ? pA[0][3] : 0.f);
                    const float prevB0 = g > 0 ? pB[t][g > 0 ? g - 1 : 0] : (t > 0 ? pB[0][3] : pA[1][3]);
                    const float prevA = h ? pA[t][g] : prevA0, prevB = h ? pB[t][g] : prevB0;
                    slab[8 * t + 2 * g + h] = ra + prevA; slab[16 + 8 * t + 2 * g + h] = rb + prevB; } }
        zero4(ot);
        pv_tile(ot, sA, lds + KBYTES, r, h); pv_tile(ot, sB, lds + BUFB + KBYTES, r, h);
    }
    __syncthreads();
    {   const int cur = qt, j = lane & 31, hf = lane >> 5;
        volatile LAS float* vb = (volatile LAS float*)(lds + XOFF + 67584 + 512) + (w * 2 + hf) * 32;
        for (int k = 0; k < 4; ++k) { const int qq = 8 * w + 2 * k + hf;
            const bool forced = (j == 0) || (j == cur) || (j == cur - 1);
            const LAS float* ip = imp + (((qq >> 5) * 32) + (qq & 31)) * 32 + j;
            const float im = (ip[0] + ip[2 * 32 * 32]) + (ip[4 * 32 * 32] + ip[6 * 32 * 32]);
            const float val = (j <= cur) ? (forced ? 1e4f : im) : NEGINF;
            vb[j] = val;
            int rank = 0;
#pragma unroll
            for (int i = 0; i < 32; ++i) { const float vi = vb[i]; rank += ((vi > val) || (vi == val && i < j)) ? 1 : 0; }
            const bool selb = (rank < 8) && (val > 0.5f * NEGINF);
            const unsigned long long bal = __ballot(selb);
            const unsigned mk = hf ? (unsigned)(bal >> 32) : (unsigned)bal;
            if (j == 0) { msk[qq] = mk; atomicOr((unsigned*)(msk + 64), mk); } }
    }
    __syncthreads();
    const unsigned mymask = msk[qi]; const unsigned uni = msk[64];
    { const float g1_ = *(const float*)((const char*)G + goff + 4u), g2_ = *(const float*)((const char*)G + goff + 8u); gpark[0] = g1_; gpark[512] = g2_; }
    {
#pragma unroll
        for (int dt = 0; dt < 4; ++dt)
#pragma unroll
            for (int g = 0; g < 4; ++g) { u32x2 wv; wv.x = pk2(ot[dt][4 * g] * g0, ot[dt][4 * g + 1] * g0); wv.y = pk2(ot[dt][4 * g + 2] * g0, ot[dt][4 * g + 3] * g0); *(LAS u32x2*)(ylds + (32 * dt + 8 * g) * 2) = wv; } }
    const int q0pos = qt * 64 + 32 * (w & 1);
    rot_q(qf, ROT, s, h);
    {   zero4(ot); float m = -1e30f, l = 0.f;
        const bf16* kbase = KS + (size_t)bg * 2048 * 128; const bf16* vbase = VST + (size_t)bg * 128 * 2048;
        unsigned rem = uni; int tcur = __ffs(rem) - 1; rem &= rem - 1;
        Stage sg; stage_load(sg, kbase + (size_t)tcur * 64 * 128, vbase + tcur * 64, 2048, nullptr, nullptr, tid); stage_write(sg, lds, false, tid);
        int tn = rem ? (__ffs(rem) - 1) : -1; rem &= rem - 1;
        if (tn >= 0) stage_load(sg, kbase + (size_t)tn * 64 * 128, vbase + tn * 64, 2048, nullptr, nullptr, tid);
        __syncthreads();
        int bsel = 0;
        while (tcur >= 0) {
            const int tn2 = rem ? (__ffs(rem) - 1) : -1; rem &= rem - 1;
            LAS unsigned char* buf = lds + bsel * BUFB;
            if (tn >= 0) stage_write(sg, lds + (bsel ^ 1) * BUFB, false, tid);
            if (tn2 >= 0) stage_load(sg, kbase + (size_t)tn2 * 64 * 128, vbase + tn2 * 64, 2048, nullptr, nullptr, tid);
            const bool mine = ((mymask >> tcur) & 1u) != 0u;
            if (__ballot(mine) != 0ull && tcur * 64 <= q0pos + 31) {
                f32x16 st[2]; s_tile_asm(st, qf, buf, r, h);
                const int k0 = tcur * 64;
                AT_SOFTMAX2(st, ot, m, l, mine, (k0 + 63 <= q0pos), (k0 + kl <= s));
                pv_tile(ot, st, buf + KBYTES, r, h);
            }
            __syncthreads();
            tcur = tn; tn = tn2; bsel ^= 1;
        }
        l += __shfl_xor(l, 32);
        {   const float sc = gpark[0] / fmaxf(l, 1e-30f);
#pragma unroll
            for (int dt = 0; dt < 4; ++dt)
#pragma unroll
                for (int g = 0; g < 4; ++g) { LAS u32x2* p = (LAS u32x2*)(ylds + (32 * dt + 8 * g) * 2); const u32x2 o = *p; u32x2 wv;
                    wv.x = pk2(lo16(o.x) + ot[dt][4 * g] * sc, hi16(o.x) + ot[dt][4 * g + 1] * sc); wv.y = pk2(lo16(o.y) + ot[dt][4 * g + 2] * sc, hi16(o.y) + ot[dt][4 * g + 3] * sc); *p = wv; } }
    }
    {   zero4(ot); float m = -1e30f, l = 0.f;
        const bf16* kbase = KW + (size_t)bg * 2048 * 128; const bf16* vbase = VWT + (size_t)bg * 128 * 2048;
        const int t0 = qt >= 8 ? qt - 8 : 0;
        Stage sg; stage_load(sg, kbase + (size_t)t0 * 64 * 128, vbase + t0 * 64, 2048, nullptr, nullptr, tid); stage_write(sg, lds, false, tid);
        if (t0 < qt) stage_load(sg, kbase + (size_t)(t0 + 1) * 64 * 128, vbase + (t0 + 1) * 64, 2048, nullptr, nullptr, tid);
        __syncthreads();
        for (int tcur = t0; tcur <= qt; ++tcur) {
            LAS unsigned char* buf = lds + ((tcur - t0) & 1) * BUFB;
            if (tcur < qt) stage_write(sg, lds + ((tcur + 1 - t0) & 1) * BUFB, false, tid);
            if (tcur + 1 < qt) stage_load(sg, kbase + (size_t)(tcur + 2) * 64 * 128, vbase + (tcur + 2) * 64, 2048, nullptr, nullptr, tid);
            if (tcur * 64 <= q0pos + 31 && tcur * 64 + 63 + 512 > q0pos) {
                f32x16 st[2]; s_tile_asm(st, qf, buf, r, h);
                const int k0 = tcur * 64;
                AT_SOFTMAX2(st, ot, m, l, true, (k0 + 63 <= q0pos && q0pos + 31 - k0 < 512), ((k0 + kl <= s) && (s - (k0 + kl) < 512)));
                pv_tile(ot, st, buf + KBYTES, r, h);
            }
            __syncthreads();
        }
        l += __shfl_xor(l, 32);
        {   const float sc = gpark[512] / fmaxf(l, 1e-30f); bf16* yrow = Y1 + ((size_t)b * 2048 + s) * 1024 + hd * 128;
#pragma unroll
            for (int dt = 0; dt < 4; ++dt)
#pragma unroll
                for (int g2 = 0; g2 < 4; g2 += 2) { u32x2 wv[2];
#pragma unroll
                    for (int k = 0; k < 2; ++k) { const int g = g2 + k; const u32x2 o = *(const LAS u32x2*)(ylds + (32 * dt + 8 * g) * 2);
                        wv[k].x = pk2(lo16(o.x) + ot[dt][4 * g] * sc, hi16(o.x) + ot[dt][4 * g + 1] * sc); wv[k].y = pk2(lo16(o.y) + ot[dt][4 * g + 2] * sc, hi16(o.y) + ot[dt][4 * g + 3] * sc); }
                    store_pair16(yrow + 32 * dt + 8 * g2, wv[0], wv[1], h); } }
    }
}
#undef DI
}

struct Args { const float* in[32]; float* out; unsigned char* ws; int ph_lo, ph_hi; };
constexpr int N_PHASES = 20;

__device__ __forceinline__ bool ph_in(int k) { const Args __attribute__((address_space(4)))* ap = (const Args __attribute__((address_space(4)))*)__builtin_amdgcn_kernarg_segment_ptr(); asm volatile("" : "+s"(ap)); return ap->ph_lo <= k && k < ap->ph_hi; }
#define INL(layer, k) ((layer) == 0 ? in[7 + (k)] : in[23 + (k)])
#define MOE_BLOCK(layer, pb) do { \
        if (IN(pb)) for (int rep_ = 0; rep_ < NREP(pb); ++rep_) { PTRS; int* cnt = ctl + CW_CNT + 512 * (layer); \
            LAS float* Wl = (LAS float*)lds; \
            stage_aux<20, 20>(Wl, INL(layer, 1), 4, 4, INL(layer, 3), 16, tid); \
            __syncthreads(); \
            LAS int* recs = (LAS int*)(lds + 122880); LAS int* lcnt = (LAS int*)(lds + 127008); LAS int* lbase = lcnt + 16; \
            if (tid < 16) lcnt[tid] = 0; \
            __syncthreads(); \
            RouteArgs a{}; a.h = HB; a.gain = INL(layer, 0); a.bg = INL(layer, 2); a.be = INL(layer, 4); a.cnt = cnt; a.list = LIST; a.listw = LISTW; _Pragma("unroll") for (int j_ = 0; j_ < 4; ++j_) a.g[j_] = *(const float4*)(a.gain + j_ * 256 + lane * 4); \
            int nrec = 0; \
            _Pragma("nounroll") for (int r = gw; r < T_ && nrec < 16; r += 2 * NGW) { RowRaw ra_, rb_; const bool two = (r + NGW < T_) && (nrec + 1 < 16); row_load(ra_, a.h, (const bf16*)nullptr, (const bf16*)nullptr, r, lane); if (two) row_load(rb_, a.h, (const bf16*)nullptr, (const bf16*)nullptr, r + NGW, lane); \
                if (two) { route_row2(a, r, r + NGW, lane, (volatile float*)(lds + 120000) + wave * 64, Wl, (volatile LAS int*)(recs + (wave * 16 + nrec) * 8), (volatile LAS int*)(recs + (wave * 16 + nrec + 1) * 8), lcnt, ra_, rb_); nrec += 2; } \
                else { route_row(a, r, lane, (volatile float*)(lds + 120000) + wave * 64, Wl, (volatile LAS int*)(recs + (wave * 16 + nrec) * 8), lcnt, ra_); ++nrec; } } \
            if (lane == 0) lcnt[32 + wave] = nrec; \
            __syncthreads(); \
            if (tid < 16) lbase[tid] = atomicAdd(&cnt[tid * 32], lcnt[tid]); \
            __syncthreads(); \
            if (tid < 256) { const int wv = tid >> 5, rr = (tid >> 1) & 15, kk = tid & 1; const LAS int* rc = recs + (wv * 16 + rr) * 8; \
                if (rr < lcnt[32 + wv]) { const int e = rc[1 + kk], pos = lbase[e] + rc[3 + kk]; LISTE[e * T_ + pos] = make_uint2((unsigned)((rc[0] << 1) | kk), (unsigned)rc[5 + kk]);        LISTR[e * T_ + pos] = ((const LAS float*)rc)[7]; } } \
            __syncthreads(); \
            if ((layer) == 0) { LAS float* scr = (LAS float*)lds; bf16* WB = (bf16*)(ws + WS_WB); CONV_RUN((int)blockIdx.x, 256, G, DEC_W2T0); }        \
        } \
        SEAM(pb); \
        if (IN(pb + 1)) for (int rep_ = 0; rep_ < NREP(pb + 1); ++rep_) { PTRS; int* cnt = ctl + CW_CNT + 512 * (layer); \
            LAS int* pre = (LAS int*)(lds + pg::MOE_TAB_OFF); \
            if (tid == 0) { int acc_ = 0; for (int e = 0; e < 16; ++e) { pre[e] = acc_; acc_ += (cnt[e * 32] + 255) >> 8; } pre[16] = acc_; } \
            __syncthreads(); \
            pg::MoeSched1 S; S.XN = HB; S.W13T = (const bf16*)(ws + WS_WB) + ((layer) == 0 ? WB_W13T0 : WB_W13T1); S.cnt = cnt; S.list = LISTE; S.ord.G = G; S.ord.vcu = vcu; S.ord.pre = pre; \
            S.pub = (unsigned*)ctl + CW_DONE + 8192 * (layer); \
            pg::EpiMoe1 E{H, cnt, LISTR}; \
            pg::gemm_phase<pg::EpiMoe1, pg::MoeSched1>((LAS unsigned char*)lds, 1024, S, E); \
            {         \
                const int ntile_ = __builtin_amdgcn_readfirstlane(pre[16]), nm1_ = 2 * ntile_, rounds_ = (nm1_ + G - 1) / G, rem_ = nm1_ - (rounds_ - 1) * G; \
                const int busy_ = rem_ < G ? rem_ : 0; int te_ = rem_ < G ? ((rounds_ - 1) * G) / 2 : ntile_; if (te_ > ntile_) te_ = ntile_; \
                const int nfree_ = G - busy_, e3_ = (4 * te_) % nfree_, nlate_ = 4 * (ntile_ - te_); \
                pg::MoeSched2 S2; S2.H = H; S2.W2T = (const bf16*)(ws + WS_WB) + ((layer) == 0 ? WB_W2T0 : WB_W2T1); S2.ord.G = G; S2.ord.vcu = vcu; S2.ord.pre = pre; S2.sub = (const unsigned*)ctl + CW_DONE + 8192 * (layer); \
                S2.busy = busy_; S2.nfree = nfree_; \
                pg::EpiMoe2 E2{cnt, LISTE, YS0, YS1, HB}; \
                S2.ubase = 0; S2.ucount = 4 * te_; S2.rot = 0;                                     \
                pg::gemm_phase<pg::EpiMoe2, pg::MoeSched2>((LAS unsigned char*)lds, 256, S2, E2); \
                S2.ubase = 4 * te_; S2.ucount = nlate_; S2.rot = e3_;                            \
                pg::gemm_phase<pg::EpiMoe2, pg::MoeSched2>((LAS unsigned char*)lds, 256, S2, E2); \
                if ((layer) == 0) {         \
                    const int k_ = vcu - busy_, lo_ = e3_ + nlate_; int slot = -1, ns = nfree_ - lo_; \
                    if (ns >= G / 4) { if (k_ >= lo_) slot = k_ - lo_; } else { slot = vcu; ns = G; } \
                    if (slot >= 0) { LAS float* scr = (LAS float*)lds; bf16* WB = (bf16*)(ws + WS_WB); CONV_RUN(slot, 160 + 64 + 128 + F8_BLOCKS, ns, DEC_P7); } } } \
        } \
        SEAM(pb + 2); \
        if (IN(pb + 3)) for (int rep_ = 0; rep_ < NREP(pb + 3); ++rep_) { PTRS; int* cnt = ctl + CW_CNT + 512 * (layer); \
            RowNormArgs a{}; a.baseh = YS0; a.add0 = YS1; a.add1 = nullptr;        \
            if (layer == 0) { LAS float* Wl = (LAS float*)lds; stage_aux<24, 28>(Wl, in[16] + 2560, 2584, 24, in[16], 2584, tid); __syncthreads(); \
                a.hout = YS0; a.gain = in[15]; _Pragma("unroll") for (int j_ = 0; j_ < 4; ++j_) a.g[j_] = *(const float4*)(a.gain + j_ * 256 + lane * 4); a.xn = XN; a.auxAct = 1; a.auxOut = Gt;     \
                _Pragma("nounroll") for (int r = gw; r < T_; r += 2 * NGW) { RowRaw ra_, rb_; const bool two = r + NGW < T_; row_load(ra_, a.baseh, a.add0, a.add1, r, lane); if (two) row_load(rb_, a.baseh, a.add0, a.add1, r + NGW, lane); \
                    if (two) rownorm_row2<24, 28>(a, r, r + NGW, lane, Wl, ra_, rb_); else rownorm_row<24, 28>(a, r, lane, Wl, ra_); } } \
            else { a.gain = in[31]; _Pragma("unroll") for (int j_ = 0; j_ < 4; ++j_) a.g[j_] = *(const float4*)(a.gain + j_ * 256 + lane * 4); a.fout = hbuf; \
                _Pragma("nounroll") for (int r = gw; r < T_; r += 2 * NGW) { RowRaw ra_, rb_; const bool two = r + NGW < T_; row_load(ra_, a.baseh, a.add0, a.add1, r, lane); if (two) row_load(rb_, a.baseh, a.add0, a.add1, r + NGW, lane); \
                    rownorm_row<0, 4>(a, r, lane, (const LAS float*)lds, ra_); if (two) rownorm_row<0, 4>(a, r + NGW, lane, (const LAS float*)lds, rb_); } } \
        } \
        if (layer == 0) SEAM(pb + 3); \
    } while (0)
__global__ void __launch_bounds__(512, 2) mk_fwd(Args args) {
    extern __shared__ __attribute__((aligned(16))) unsigned char lds[];
    typedef const Args __attribute__((address_space(4)))* KArgP;
#define in AP->in
    for (int u = threadIdx.x; u < (LDS_BYTES - LDSCTL_OFF) / 4; u += 512) ((LAS unsigned*)(lds + LDSCTL_OFF))[u] = 0u;
    __syncthreads();
    (void)xcd_barrier_post((unsigned*)(args.ws + WS_CTL) + CW_BAR, (volatile LAS unsigned*)(lds + MISC_OFF) + 8);
#ifndef PHMASK
#define PHMASK 0xFFFFFu
#endif
#ifndef REPMASK
#define REPMASK 0u
#endif
#define NREP(k) ((((REPMASK) >> (k)) & 1u) ? 2 : 1)
#define IN(k) (((PHMASK >> (k)) & 1u) && ph_in(k))
#define SEAM2(k, k2) do { if (IN(k) && IN(k2)) { KArgP AB = (KArgP)__builtin_amdgcn_kernarg_segment_ptr(); asm volatile("" : "+s"(AB)); \
        XcdBarrier bar_; bar_.bar = (unsigned*)(AB->ws + WS_CTL) + CW_BAR; bar_.x = xb_xcc_id(); bar_.st = (volatile LAS unsigned*)(lds + MISC_OFF) + 8; xcd_barrier(bar_); } } while (0)
#define SEAM(k) SEAM2(k, (k) + 1)

#define PTRS \
    KArgP AP = (KArgP)__builtin_amdgcn_kernarg_segment_ptr(); asm volatile("" : "+s"(AP)); \
    int tid = threadIdx.x; asm volatile("" : "+v"(tid)); const int lane = tid & 63; const size_t gtid = (size_t)blockIdx.x * 512 + tid; (void)lane; (void)gtid; \
    const int wave = __builtin_amdgcn_readfirstlane(tid >> 6); const int G = gridDim.x, gw = blockIdx.x * 8 + wave, NGW = G * 8; const size_t NGT = (size_t)G * 512; (void)gw; (void)NGW; (void)NGT; \
    const int vcu = (G % 8 == 0) ? ((int)blockIdx.x % 8) * (G / 8) + (int)blockIdx.x / 8 : (int)blockIdx.x; (void)vcu; \
    int* ctl = (int*)(AP->ws + WS_CTL); (void)ctl; float* ldsf = (float*)lds; (void)ldsf; \
    volatile float* wq = (volatile float*)(lds + 32768) + wave * 256; volatile float* wp = wq + 128; (void)wq; (void)wp; \
    unsigned char* ws = AP->ws; float* hbuf = AP->out; \
    bf16* XN = (bf16*)(ws + WS_R0); \
    unsigned char* sm = ws + WS_SM; \
    float* IFr = (float*)(sm + SM_IF); float* LI = (float*)(sm + SM_LI); float* BC = (float*)(sm + SM_BC); \
    int* LIST = (int*)(sm + SM_LIST); float* LISTW = (float*)(sm + SM_LISTW); (void)LIST; (void)LISTW; uint2* LISTE = (uint2*)(sm + SM_LIST); (void)LISTE; float* LISTR = (float*)(sm + SM_LISTR); (void)LISTR; unsigned* SELM = (unsigned*)(sm + SM_SELM); float* Gt = (float*)(sm + SM_G); \
    bf16* HC = (bf16*)(sm + SM_HC); bf16* KCMP = (bf16*)(sm + SM_KCMP); bf16* VCMPT = (bf16*)(sm + SM_VCMPT); (void)HC; \
    float2* ROT = (float2*)(sm + SM_ROT); float* CB = (float*)(sm + SM_CB); float* PART = (float*)(ws + WS_R3); (void)ROT; (void)CB; (void)PART; \
    bf16* QKraw = (bf16*)(ws + WS_R1); bf16* OM = (bf16*)(ws + WS_R2); bf16* QB = (bf16*)(ws + WS_R2 + 16 * MiB); \
    bf16* KB = (bf16*)(ws + WS_R3); bf16* VMT = (bf16*)(ws + WS_R3 + 16 * MiB); bf16* VBT = (bf16*)(ws + WS_R4); \
    bf16* QM = (bf16*)(ws + WS_R0); bf16* KM = (bf16*)(ws + WS_R0 + 16 * MiB); \
    bf16* Y0 = (bf16*)(ws + WS_R1); \
    bf16* Q1 = (bf16*)(ws + WS_R1); bf16* Q1R = (bf16*)(ws + WS_R2); bf16* OC = (bf16*)(ws + WS_R3); \
    bf16* KC = (bf16*)(ws + WS_R4); bf16* VC = (bf16*)(ws + WS_R4 + 8 * MiB); bf16* KS = (bf16*)(ws + WS_R4 + 16 * MiB); bf16* KW = (bf16*)(ws + WS_R4 + 24 * MiB); \
    bf16* VST = (bf16*)(ws + WS_R5); bf16* VWT = (bf16*)(ws + WS_R5 + 8 * MiB); \
    bf16* Y1 = (bf16*)(ws + WS_R0); \
    bf16* H = (bf16*)(ws + WS_R1); bf16* YS0 = (bf16*)(ws + WS_R2); bf16* YS1 = (bf16*)(ws + WS_R3); bf16* HB = (bf16*)(ws + WS_R4); (void)HB; \
    (void)0
    if (IN(0)) for (int rep_ = 0; rep_ < NREP(0); ++rep_) { PTRS;
        LAS float* Wl = (LAS float*)lds;
        __syncthreads();
        stage_aux<8, 12>(Wl, in[2] + 2048, 3592, 8, in[2], 3592, tid);
        __syncthreads();
        RowNormArgs a{}; a.base = in[0]; a.gain = in[1]; a.xn = XN; a.auxAct = 0; a.auxOut = IFr;
#pragma unroll
        for (int j_ = 0; j_ < 4; ++j_) a.g[j_] = *(const float4*)(a.gain + j_ * 256 + lane * 4);
#pragma nounroll
        for (int r = gw; r < T_; r += 2 * NGW) { RowRaw ra_, rb_; const bool two = r + NGW < T_; row_load(ra_, a.base, (const bf16*)nullptr, (const bf16*)nullptr, r, lane); if (two) row_load(rb_, a.base, (const bf16*)nullptr, (const bf16*)nullptr, r + NGW, lane);
            if (two) rownorm_row2<8, 12>(a, r, r + NGW, lane, Wl, ra_, rb_); else rownorm_row<8, 12>(a, r, lane, Wl, ra_); }
        __syncthreads();
        for (size_t i = gtid; i < (size_t)2048 * 64; i += NGT) { const int pos = (int)(i >> 6), fi = (int)(i & 63);
            const float ang = (float)pos * __builtin_amdgcn_exp2f(-(float)fi * (13.287712379549449f / 64.f));
            ROT[i] = make_float2(__cosf(ang), __sinf(ang)); }
        LAS float* scr = (LAS float*)lds;
        bf16* WB = (bf16*)(ws + WS_WB);
        CONV_RUN((int)blockIdx.x, 224, G, DEC_P0);
    }
    SEAM(0);
#ifdef XBAR_TEST
    for (int xb_ = 0; xb_ < 20; ++xb_) { SEAM(0); }
#endif
    if (IN(1)) for (int rep_ = 0; rep_ < NREP(1); ++rep_) { PTRS;
        const bf16* W0T = (const bf16*)(ws + WS_WB) + WB_W0T;
        {   pg::DenseSched S; S.A = XN; S.lda = 1024; S.Bt = W0T; S.K = 1024; S.ord.init(64, 10, G, (int)blockIdx.x);
            pg::EpiProj0 E{QKraw, OM, QB, KB, ROT};
            pg::gemm_phase<pg::EpiProj0, pg::DenseSched>((LAS unsigned char*)lds, 1024, S, E); }
        {   pg::DenseSched S; S.A = W0T + (size_t)2560 * 1024; S.lda = 1024; S.Bt = XN; S.K = 1024; S.ord.init(4, 64, G, (int)blockIdx.x);
            pg::EpiVT0 E{VMT, VBT};
            pg::gemm_phase<pg::EpiVT0, pg::DenseSched>((LAS unsigned char*)lds, 1024, S, E); }
        {   int slot, ns;
            if (fill_slot(640 + 256, G, (int)blockIdx.x, slot, ns)) { LAS float* scr = (LAS float*)lds; bf16* WB = (bf16*)(ws + WS_WB);
                CONV_RUN(slot, 64 + 512, ns, DEC_P1); } }
    }
    SEAM(1);
    if (IN(2)) for (int rep_ = 0; rep_ < NREP(2); ++rep_) { PTRS;
        const bool late_conv = (blockIdx.x & 1u) != 0u;
        if (!late_conv) for (int i = (int)gtid; i < (T_ / 16) * 128; i += (int)NGT) conv_silu_run(i, QKraw, in[3], QM, KM);
        for (int bhq = blockIdx.x; bhq < 32; bhq += G) gates_block(bhq, tid, IFr, in[4], LI, BC, (LAS float*)(lds + 4096));
        {   float* KMEAN = (float*)(sm + SM_KMEAN);
            LAS float* red = (LAS float*)(lds + 8192);
            const int kfirst = G > 64 ? (int)blockIdx.x - 32 : (int)blockIdx.x, kstep = G > 64 ? G - 32 : G;
            for (int it = kfirst; it < 256; it += kstep) { if (it < 0) break; float acc[8];
#pragma unroll
                for (int e = 0; e < 8; ++e) acc[e] = 0.f;
                const bf16* kp = KB + ((size_t)it * 256 + wave * 32 + (lane >> 4)) * 128 + (lane & 15) * 8;
#pragma unroll
                for (int j = 0; j < 8; ++j) { const uint4 u = *(const uint4*)(kp + (size_t)j * 4 * 128);
                    acc[0] += lo16(u.x); acc[1] += hi16(u.x); acc[2] += lo16(u.y); acc[3] += hi16(u.y); acc[4] += lo16(u.z); acc[5] += hi16(u.z); acc[6] += lo16(u.w); acc[7] += hi16(u.w); }
#pragma unroll
                for (int e = 0; e < 8; ++e) { acc[e] = pair16(acc[e], acc[e]); acc[e] = pair32(acc[e], acc[e]); }
                __syncthreads();
                if (lane < 16) {
#pragma unroll
                    for (int e = 0; e < 8; ++e) red[wave * 128 + lane * 8 + e] = acc[e]; }
                __syncthreads();
                if (tid < 128) { float sacc = 0.f;
#pragma unroll
                    for (int q = 0; q < 8; ++q) sacc += red[q * 128 + tid];
                    KMEAN[it * 128 + tid] = sacc * (1.f / 256.f); } } }
        if (late_conv) for (int i = (int)gtid; i < (T_ / 16) * 128; i += (int)NGT) conv_silu_run(i, QKraw, in[3], QM, KM);
    }
    SEAM2(2, 4);
    if (IN(4)) for (int rep_ = 0; rep_ < NREP(4); ++rep_) { PTRS;
        const float* KMEAN = (const float*)(sm + SM_KMEAN);
        for (int u = vcu; u < 256; u += G) { const int bh = u >> 3, qb = u & 7;
            at::mlstm_unit(bh, qb, (LAS unsigned char*)lds, QM, KM, VMT, LI, BC, OM, in[5], Y0);
            at::moba_unit(bh, 7 - qb, (LAS unsigned char*)lds, QB, KB, VBT, KMEAN, Y0); }
    }
    SEAM(4);
    if (IN(5)) for (int rep_ = 0; rep_ < NREP(5); ++rep_) { PTRS;
        pg::DenseSched S; S.A = Y0; S.lda = 1024; S.Bt = (const bf16*)(ws + WS_WB) + WB_WO0T; S.K = 1024; S.ord.init(64, 4, G, (int)blockIdx.x);
        pg::EpiOut<false> E{in[0], HB};
        pg::gemm_phase<pg::EpiOut<false>, pg::DenseSched>((LAS unsigned char*)lds, 1024, S, E);
    }
    SEAM(5);
    MOE_BLOCK(0, 6);
            if (IN(10)) for (int rep_ = 0; rep_ < NREP(10); ++rep_) { PTRS;
                const bf16* W1T = (const bf16*)(ws + WS_WB) + WB_W1T;
                {   pg::DenseSched S; S.A = XN; S.lda = 1024; S.Bt = W1T; S.K = 1024; S.ord.init(64, 8, G, (int)blockIdx.x);
                    pg::EpiProj1 E{Q1, KC, VC, KS, KW, ROT};
                    pg::gemm_phase<pg::EpiProj1, pg::DenseSched>((LAS unsigned char*)lds, 1024, S, E); }
            }
            SEAM(10);
            if (IN(11)) for (int rep_ = 0; rep_ < NREP(11); ++rep_) { PTRS;
                const bf16* W1T = (const bf16*)(ws + WS_WB) + WB_W1T;
                const int nvt = G >= 192 ? (G * 2) / 3 : G;
                if ((int)blockIdx.x < nvt || G < 192) {
                    pg::DenseSched S; S.A = W1T + (size_t)2048 * 1024; S.lda = 1024; S.Bt = XN; S.K = 1024; S.ord.init(2, 64, nvt, (int)blockIdx.x);
                    pg::EpiVT1 E{VST, VWT};
                    pg::gemm_phase<pg::EpiVT1, pg::DenseSched>((LAS unsigned char*)lds, 1024, S, E); }
                if ((int)blockIdx.x >= nvt || G < 192) {
                    pg::CmpSched S; S.KC = KC; S.VC = VC; S.WK = (const bf16*)(ws + WS_WB) + WB_CK1T; S.WV = (const bf16*)(ws + WS_WB) + WB_CV1T; S.G = G < 192 ? G : G - nvt; S.c = G < 192 ? (int)blockIdx.x : (int)blockIdx.x - nvt;
                    pg::EpiCmp1 E{(bf16*)PART};
                    pg::gemm_phase<pg::EpiCmp1, pg::CmpSched>((LAS unsigned char*)lds, 1024, S, E, 4096); }
                {   int slot = (int)blockIdx.x, ns = G; bool idle = true;
                    if (G >= 192) { const int b = (int)blockIdx.x;
                        if (b < nvt) { idle = b >= 128; slot = b - 128; } else { idle = b - nvt >= 64; slot = (nvt - 128) + (b - nvt - 64); }
                        ns = G - 192; if (ns <= 0) { idle = true; slot = b; ns = G; } }
                    if (idle) { LAS float* scr = (LAS float*)lds; bf16* WB = (bf16*)(ws + WS_WB);
        {
            LAS float* red = (LAS float*)(lds + 16384);
            for (int o0 = slot; o0 < 256; o0 += ns) { const int o = o0 + 256 * (wave >> 2), kv = o >> 8, n = o & 255, kq = wave & 3;
                const bf16* wrow = (const bf16*)(ws + WS_WB) + (kv ? WB_CV1T : WB_CK1T) + (size_t)n * 4096 + kq * 1024; const float* pe = in[17] + kv * 4096 + kq * 1024;
                float acc = 0.f;
#pragma unroll
                for (int jj = 0; jj < 2; ++jj) { const int j = lane * 8 + jj * 512; const uint4 u = *(const uint4*)(wrow + j); const float4 p0 = *(const float4*)(pe + j), p1 = *(const float4*)(pe + j + 4);
                    acc += p0.x * lo16(u.x) + p0.y * hi16(u.x) + p0.z * lo16(u.y) + p0.w * hi16(u.y) + p1.x * lo16(u.z) + p1.y * hi16(u.z) + p1.z * lo16(u.w) + p1.w * hi16(u.w); }
                acc = wave_sum(acc);
                __syncthreads();
                if (lane == 0) red[wave] = acc;
                __syncthreads();
                if (tid < 2) CB[o0 + 256 * tid] = (red[4 * tid] + red[4 * tid + 1]) + (red[4 * tid + 2] + red[4 * tid + 3]); } }
                        CONV_RUN(F8_BLOCKS + slot, F8_BLOCKS + F11_BLOCKS, ns, DEC_M1); } }
            }
            SEAM(11);
            if (IN(12)) for (int rep_ = 0; rep_ < NREP(12); ++rep_) { PTRS;
                typedef float f4v __attribute__((ext_vector_type(4)));
                LAS float* As2 = (LAS float*)lds;
                LAS float* red = (LAS float*)(lds + 32768);
                for (int item = blockIdx.x; item < 256; item += G) { const int z = item >> 7, rt = item & 127;
                    __syncthreads();
                    for (int idx = tid; idx < 16 * 64; idx += 512) { const int row = idx & 15, k4 = idx >> 4; const int rr = rt * 16 + row;
                        float4 sa = *(const float4*)(CB + z * 256 + 4 * k4);
#pragma unroll
                        for (int ks = 0; ks < 4; ++ks) { const uint2 p = *(const uint2*)((const bf16*)PART + ((size_t)(ks * 2 + z) * 2048 + rr) * 256 + 4 * k4); sa.x += lo16(p.x); sa.y += hi16(p.x); sa.z += lo16(p.y); sa.w += hi16(p.y); }
                        const float vv[4] = {sa.x, sa.y, sa.z, sa.w};
#pragma unroll
                        for (int j = 0; j < 4; ++j) { const float u = 0.7978845608028654f * (vv[j] + 0.044715f * vv[j] * vv[j] * vv[j]); As2[(4 * k4 + j) * 20 + row] = bf2f(f2bf(vv[j] * __builtin_amdgcn_rcpf(1.f + __builtin_amdgcn_exp2f(-2.8853900817779268f * u)))); }        }
                    __syncthreads();
                    {   const int kq = tid >> 7, tx = tid & 31, ty = (tid >> 5) & 3;
                        const float* W2 = (z ? in[21] : in[19]) + (size_t)kq * 64 * 128 + tx * 4;
                        const LAS float* Ap = As2 + kq * 64 * 20 + 4 * ty;
                        f4v acc0 = {0.f, 0.f, 0.f, 0.f}, acc1 = acc0, acc2 = acc0, acc3 = acc0;
#pragma unroll 8
                        for (int kk = 0; kk < 64; ++kk) { const f4v w = *(const f4v*)(W2 + (size_t)kk * 128); const f4v a4 = *(const LAS f4v*)(Ap + kk * 20);
                            acc0 += a4.x * w; acc1 += a4.y * w; acc2 += a4.z * w; acc3 += a4.w * w; }
                        LAS f4v* rp = (LAS f4v*)(red + (kq * 16 + 4 * ty) * 128 + 4 * tx);
                        rp[0] = acc0; rp[32] = acc1; rp[64] = acc2; rp[96] = acc3; }
                    __syncthreads();
                    if (z == 0) { const int row = tid >> 5, c4 = tid & 31; const LAS f4v* rp = (const LAS f4v*)(red + row * 128 + 4 * c4);
                        f4v sv = (rp[0] + rp[512]) + (rp[1024] + rp[1536]);
                        const int r = rt * 16 + row, bgq = r >> 7, nb = r & 127; if (nb == 127) sv = f4v{0.f, 0.f, 0.f, 0.f};
                        *(uint2*)(KCMP + ((size_t)bgq * 128 + nb) * 128 + 4 * c4) = make_uint2(pk2(sv.x, sv.y), pk2(sv.z, sv.w)); }
                    else { const int n = tid >> 2, r4 = tid & 3; float sv[4];
#pragma unroll
                        for (int i = 0; i < 4; ++i) { const LAS float* rp = red + (4 * r4 + i) * 128 + n; sv[i] = (rp[0] + rp[2048]) + (rp[4096] + rp[6144]); }
                        const int r = rt * 16 + 4 * r4, bgq = r >> 7, nb = r & 127; if (nb + 3 == 127) sv[3] = 0.f;
                        *(uint2*)(VCMPT + ((size_t)bgq * 128 + n) * 128 + nb) = make_uint2(pk2(sv[0], sv[1]), pk2(sv[2], sv[3])); }
                }
            }
            SEAM2(12, 14);
            if (IN(14)) for (int rep_ = 0; rep_ < NREP(14); ++rep_) { PTRS;
                for (int u = vcu; u < 256; u += G) { const int bg = u >> 4, p = u & 15;
                    at::nsa_unit(bg, p, (LAS unsigned char*)lds, Q1, ROT, KCMP, VCMPT, KS, VST, KW, VWT, Gt, Y1);
                    at::nsa_unit(bg, 31 - p, (LAS unsigned char*)lds, Q1, ROT, KCMP, VCMPT, KS, VST, KW, VWT, Gt, Y1); }
            }
            if (IN(14)) { PTRS;
                if (G == 256) { const int bg = vcu >> 4, p = vcu & 15;
                    if (p < 8) { const int off = p == 0 ? 0 : p == 1 ? 4 : p == 2 ? 7 : p == 3 ? 10 : p == 4 ? 12 : p == 5 ? 14 : p == 6 ? 16 : 17, cnt = p == 0 ? 4 : p < 3 ? 3 : p < 6 ? 2 : 1;
                        const int first = F8_BLOCKS + F11_BLOCKS + bg * 18 + off; LAS float* scr = (LAS float*)lds; bf16* WB = (bf16*)(ws + WS_WB);
                        CONV_RUN(first, first + cnt, 1, DEC_M1); } }
                else { LAS float* scr = (LAS float*)lds; bf16* WB = (bf16*)(ws + WS_WB); CONV_RUN(F8_BLOCKS + F11_BLOCKS + (int)blockIdx.x, 512 + 256, G, DEC_M1); }
            }
            SEAM(14);
            if (IN(15)) for (int rep_ = 0; rep_ < NREP(15); ++rep_) { PTRS;
                pg::DenseSched S; S.A = Y1; S.lda = 1024; S.Bt = (const bf16*)(ws + WS_WB) + WB_WO1T; S.K = 1024; S.ord.init(64, 4, G, (int)blockIdx.x);
                pg::EpiOut<true> E{YS0, HB};
                pg::gemm_phase<pg::EpiOut<true>, pg::DenseSched>((LAS unsigned char*)lds, 1024, S, E);
            }
            SEAM(15);
    MOE_BLOCK(1, 16);
#undef IN
#undef SEAM
#undef in
}

extern "C" void kernel_launch(void* const* d_in, const int* in_sizes, int n_in, void* d_out, int out_size, void* d_ws, size_t ws_size, hipStream_t stream) {
    (void)in_sizes; (void)out_size; (void)ws_size;
    static int grid = 0;
    if (grid == 0) {
        int dev = 0, cus = 0, per_cu = 0;
        if (hipGetDevice(&dev) != hipSuccess || hipDeviceGetAttribute(&cus, hipDeviceAttributeMultiprocessorCount, dev) != hipSuccess) { grid = -1; return; }
        if (hipFuncSetAttribute((const void*)mk_fwd, hipFuncAttributeMaxDynamicSharedMemorySize, LDS_BYTES) != hipSuccess) { fprintf(stderr, "hipFuncSetAttribute failed\n"); grid = -1; return; }
        if (hipOccupancyMaxActiveBlocksPerMultiprocessor(&per_cu, (const void*)mk_fwd, 512, LDS_BYTES) != hipSuccess || per_cu < 1) fprintf(stderr, "occupancy query: %d\n", per_cu);
        (void)hipGetLastError();
        grid = cus;
    }
    if (grid < 0) return;
    if (hipMemsetAsync((char*)d_ws + WS_CTL, 0, CTL_ZERO_BYTES, stream) != hipSuccess) return;
    Args a{};
    for (int i = 0; i < 32 && i < n_in; ++i) a.in[i] = (const float*)d_in[i];
    a.out = (float*)d_out; a.ws = (unsigned char*)d_ws; a.ph_lo = 0; a.ph_hi = N_PHASES;
    hipLaunchKernelGGL(mk_fwd, dim3(grid), dim3(512), LDS_BYTES, stream, a);
}
```
